# Optimizing an MI355X kernel written in HIP

```python
import jax, jax.numpy as jnp
from jax import lax
import numpy as np

D_MODEL = 1024
BATCH = 8
SEQ = 2048
DEPTH = 4

CTX_LEN = 256
GRID_W = 64
HEAD_DIM = 64
N_MOD = 9
D_FF = 2816
EPS = 1e-6
NEG_INF = -1e30
NA_HEADS = 4
NA_WIN_H_MAX = 8
NA_WIN_W = 16
NA_QCB = 16
NA_KCB = 32
NA_WIDTH = NA_HEADS * HEAD_DIM
POOL_WINDOWS = (2, 4, 8, 16)
POOL_GROUPS = 4
POOL_WIDTH = 256
POOL_GC = POOL_WIDTH // POOL_GROUPS
GQA_Q_HEADS = 8
GQA_KV_HEADS = 2
GQA_GROUP = GQA_Q_HEADS // GQA_KV_HEADS
GQA_QB = 128
GQA_Q_WIDTH = GQA_Q_HEADS * HEAD_DIM
GQA_KV_WIDTH = GQA_KV_HEADS * HEAD_DIM
ROPE_THETA = 10000.0
OFF_A_Q = 0
OFF_A_K = OFF_A_Q + NA_WIDTH
OFF_A_V = OFF_A_K + NA_WIDTH
OFF_B_U = OFF_A_V + NA_WIDTH
OFF_C_Q = OFF_B_U + POOL_WIDTH
OFF_C_K = OFF_C_Q + GQA_Q_WIDTH
OFF_C_V = OFF_C_K + GQA_KV_WIDTH
D_IN = OFF_C_V + GQA_KV_WIDTH
D_MIX = NA_WIDTH + POOL_WIDTH + GQA_Q_WIDTH

kernel_name = 'hybrid_na_pool_gqa_macaron_dit'


def _rmsnorm(x, g):
    x32 = x.astype(jnp.float32)
    y = x32 * lax.rsqrt(jnp.mean(x32 * x32, axis=-1, keepdims=True) + EPS)
    return (y * g.astype(jnp.float32)).astype(x.dtype)


def _modulate(h, shift, scale):
    return h * (1 + scale) + shift


def _swiglu(h, w_up, w_down):
    a, b = jnp.split(h @ w_up, 2, axis=-1)
    return (jax.nn.silu(a) * b) @ w_down


def _half_ffn(h, g, shift, scale, gate, w_up, w_down):
    return h + 0.5 * gate * _swiglu(_modulate(_rmsnorm(h, g), shift, scale), w_up, w_down)


def _rope_axis(x, ang):
    m = x.shape[-1] // 2
    x32 = x.astype(jnp.float32)
    x1, x2 = x32[..., :m], x32[..., m:]
    cos = jnp.cos(ang)[:, None, :]
    sin = jnp.sin(ang)[:, None, :]
    return jnp.concatenate([x1 * cos - x2 * sin, x1 * sin + x2 * cos], axis=-1)


def _rope_2d(x, ang_row, ang_col):
    half = x.shape[-1] // 2
    out = jnp.concatenate([_rope_axis(x[..., :half], ang_row), _rope_axis(x[..., half:], ang_col)], axis=-1)
    return out.astype(x.dtype)


def _gqa_attend(q, k, v):
    s = jnp.einsum('bqkgd,bskd->bkgqs', q, k, preferred_element_type=jnp.float32) * (q.shape[-1] ** -0.5)
    p = jax.nn.softmax(s, axis=-1).astype(v.dtype)
    return jnp.einsum('bkgqs,bskd->bqkgd', p, v)


def _gqa_blocks(q, k_all, v_all):
    bn, n = q.shape[0], q.shape[1]
    nqb = n // GQA_QB
    qb = q.reshape(bn, nqb, GQA_QB, GQA_KV_HEADS, GQA_GROUP, HEAD_DIM).transpose(1, 0, 2, 3, 4, 5)
    o = lax.map(lambda blk: _gqa_attend(blk, k_all, v_all), qb)
    return o.transpose(1, 0, 2, 3, 4, 5).reshape(bn, n, GQA_Q_WIDTH)


def _neighbourhood_attn(q, k, v, k_ctx, v_ctx, rpb):
    bn, n, nh, dh = q.shape
    rows = n // GRID_W
    kh = min(NA_WIN_H_MAX, rows)
    ncb = GRID_W // NA_QCB
    col = jnp.arange(GRID_W)
    win_c0 = jnp.clip(col - NA_WIN_W // 2, 0, GRID_W - NA_WIN_W)
    blk_c0 = jnp.clip(win_c0[::NA_QCB], 0, GRID_W - NA_KCB)
    key_col = blk_c0[:, None] + jnp.arange(NA_KCB)
    q_c0 = win_c0.reshape(ncb, NA_QCB)[:, :, None]
    kc = key_col[:, None, :]
    valid = (kc >= q_c0) & (kc < q_c0 + NA_WIN_W)
    dx = kc - col.reshape(ncb, NA_QCB)[:, :, None]
    dx_idx = jnp.clip(dx, -(NA_WIN_W - 1), NA_WIN_W - 1) + NA_WIN_W - 1
    scale = dh ** -0.5
    q_grid = q.reshape(bn, rows, ncb, NA_QCB, nh, dh)

    def one_row(r):
        q_r = lax.dynamic_index_in_dim(q_grid, r, axis=1, keepdims=False)
        r0 = jnp.clip(r - kh // 2, 0, rows - kh)
        key_row = r0 + jnp.arange(kh)
        tok = key_row[None, :, None] * GRID_W + key_col[:, None, :]
        k_blk = k[:, tok]
        v_blk = v[:, tok]
        s_lat = jnp.einsum('bjqhd,bjykhd->bhjqyk', q_r, k_blk, preferred_element_type=jnp.float32) * scale
        dy_idx = key_row - r + NA_WIN_H_MAX - 1
        bias = rpb[:, dy_idx[None, None, :, None], dx_idx[:, :, None, :]]
        s_lat = jnp.where(valid[:, :, None, :], s_lat + bias.astype(jnp.float32), NEG_INF)
        s_lat = s_lat.reshape(bn, nh, ncb, NA_QCB, kh * NA_KCB)
        s_ctx = jnp.einsum('bjqhd,bchd->bhjqc', q_r, k_ctx, preferred_element_type=jnp.float32) * scale
        p = jax.nn.softmax(jnp.concatenate([s_lat, s_ctx], axis=-1), axis=-1).astype(v.dtype)
        p_lat = p[..., :kh * NA_KCB].reshape(bn, nh, ncb, NA_QCB, kh, NA_KCB)
        p_ctx = p[..., kh * NA_KCB:]
        o = jnp.einsum('bhjqyk,bjykhd->bjqhd', p_lat, v_blk) + jnp.einsum('bhjqc,bchd->bjqhd', p_ctx, v_ctx)
        return o.reshape(bn, GRID_W, nh, dh)

    o = lax.map(one_row, jnp.arange(rows))
    return o.transpose(1, 0, 2, 3, 4).reshape(bn, n, nh * dh)


def _pool_mix(u, w_pool, scale):
    bn, n, _ = u.shape
    u32 = u.astype(jnp.float32)
    cs = jnp.concatenate([jnp.zeros_like(u32[:, :1]), jnp.cumsum(u32, axis=1)], axis=1)
    cs = cs.reshape(bn, n + 1, POOL_GROUPS, POOL_GC)
    t = jnp.arange(n)[:, None]
    win = jnp.array(POOL_WINDOWS, dtype=jnp.int32)[None, :]
    lo = jnp.clip(t - win // 2, 0, n)
    hi = jnp.clip(t - win // 2 + win, 0, n)
    g_idx = jnp.arange(POOL_GROUPS)[None, :]
    sums = cs[:, hi, g_idx] - cs[:, lo, g_idx]
    mean = sums / (hi - lo).astype(jnp.float32)[None, :, :, None]
    y = (mean - u32.reshape(bn, n, POOL_GROUPS, POOL_GC)).astype(u.dtype)
    y = jnp.einsum('blgc,gcd->blgd', y, w_pool)
    return y.reshape(bn, n, POOL_WIDTH) * scale


def setup_inputs(seed: int = 0) -> dict:
    key = jax.random.key(seed)
    ks = jax.random.split(key, 20)
    nrm = jax.random.normal
    f32 = jnp.float32
    return {
        'x': nrm(ks[0], (BATCH, SEQ, D_MODEL), f32),
        'c': nrm(ks[1], (BATCH, D_MODEL), f32),
        'ctx': nrm(ks[2], (BATCH, CTX_LEN, D_MODEL), f32),
        'c_ctx': nrm(ks[3], (D_MODEL,), f32),
        'w_ada': nrm(ks[4], (DEPTH, D_MODEL, N_MOD * D_MODEL), f32) * D_MODEL ** -0.5,
        'b_ada': nrm(ks[5], (DEPTH, N_MOD * D_MODEL), f32) * 0.02,
        'norm_g': 1.0 + 0.05 * nrm(ks[6], (DEPTH, 3, D_MODEL), f32),
        'ffn1_up': nrm(ks[7], (DEPTH, D_MODEL, 2 * D_FF), f32) * D_MODEL ** -0.5,
        'ffn1_down': nrm(ks[8], (DEPTH, D_FF, D_MODEL), f32) * D_FF ** -0.5,
        'ffn2_up': nrm(ks[9], (DEPTH, D_MODEL, 2 * D_FF), f32) * D_MODEL ** -0.5,
        'ffn2_down': nrm(ks[10], (DEPTH, D_FF, D_MODEL), f32) * D_FF ** -0.5,
        'w_in': nrm(ks[11], (DEPTH, D_MODEL, D_IN), f32) * D_MODEL ** -0.5,
        'w_out': nrm(ks[12], (DEPTH, D_MIX, D_MODEL), f32) * D_MIX ** -0.5,
        'na_rpb': nrm(ks[13], (DEPTH, NA_HEADS, 2 * NA_WIN_H_MAX - 1, 2 * NA_WIN_W - 1), f32) * 0.1,
        'pool_w': nrm(ks[14], (DEPTH, POOL_GROUPS, POOL_GC, POOL_GC), f32) * POOL_GC ** -0.5,
        'pool_scale': 1.0 + 0.1 * nrm(ks[15], (DEPTH, POOL_WIDTH), f32),
        'q_norm_g': 1.0 + 0.05 * nrm(ks[16], (DEPTH, HEAD_DIM), f32),
        'k_norm_g': 1.0 + 0.05 * nrm(ks[17], (DEPTH, HEAD_DIM), f32),
        'final_g': 1.0 + 0.05 * nrm(ks[18], (D_MODEL,), f32),
    }


def reference(x, c, ctx, c_ctx, w_ada, b_ada, norm_g, ffn1_up, ffn1_down, ffn2_up, ffn2_down,
              w_in, w_out, na_rpb, pool_w, pool_scale, q_norm_g, k_norm_g, final_g):
    bn, n, d = x.shape
    ncx = ctx.shape[1]
    pos = jnp.arange(n)
    inv_freq = ROPE_THETA ** (-jnp.arange(0, HEAD_DIM // 2, 2, dtype=jnp.float32) / (HEAD_DIM // 2))
    ang_row = (pos // GRID_W).astype(jnp.float32)[:, None] * inv_freq[None, :]
    ang_col = (pos % GRID_W).astype(jnp.float32)[:, None] * inv_freq[None, :]
    h_x, h_c = x, ctx
    for l in range(DEPTH):
        last = l == DEPTH - 1
        mod_x = (jax.nn.silu(c) @ w_ada[l] + b_ada[l]).reshape(bn, 1, N_MOD, d)
        mod_c = (jax.nn.silu(c_ctx) @ w_ada[l] + b_ada[l]).reshape(1, 1, N_MOD, d)
        h_x = _half_ffn(h_x, norm_g[l, 0], mod_x[:, :, 0], mod_x[:, :, 1], mod_x[:, :, 2], ffn1_up[l], ffn1_down[l])
        h_c = _half_ffn(h_c, norm_g[l, 0], mod_c[:, :, 0], mod_c[:, :, 1], mod_c[:, :, 2], ffn1_up[l], ffn1_down[l])
        a_x = _modulate(_rmsnorm(h_x, norm_g[l, 1]), mod_x[:, :, 3], mod_x[:, :, 4])
        a_c = _modulate(_rmsnorm(h_c, norm_g[l, 1]), mod_c[:, :, 3], mod_c[:, :, 4])
        p_x = a_x @ w_in[l]
        kv_a_c = a_c @ w_in[l][:, OFF_A_K:OFF_B_U]
        kv_c_c = a_c @ w_in[l][:, OFF_C_K:D_IN]
        q_a = p_x[..., OFF_A_Q:OFF_A_K].reshape(bn, n, NA_HEADS, HEAD_DIM)
        k_a = p_x[..., OFF_A_K:OFF_A_V].reshape(bn, n, NA_HEADS, HEAD_DIM)
        v_a = p_x[..., OFF_A_V:OFF_B_U].reshape(bn, n, NA_HEADS, HEAD_DIM)
        k_a_c = kv_a_c[..., :NA_WIDTH].reshape(bn, ncx, NA_HEADS, HEAD_DIM)
        v_a_c = kv_a_c[..., NA_WIDTH:].reshape(bn, ncx, NA_HEADS, HEAD_DIM)
        q_c = _rope_2d(_rmsnorm(p_x[..., OFF_C_Q:OFF_C_K].reshape(bn, n, GQA_Q_HEADS, HEAD_DIM), q_norm_g[l]), ang_row, ang_col)
        q_c = q_c.reshape(bn, n, GQA_KV_HEADS, GQA_GROUP, HEAD_DIM)
        k_c = _rope_2d(_rmsnorm(p_x[..., OFF_C_K:OFF_C_V].reshape(bn, n, GQA_KV_HEADS, HEAD_DIM), k_norm_g[l]), ang_row, ang_col)
        v_c = p_x[..., OFF_C_V:D_IN].reshape(bn, n, GQA_KV_HEADS, HEAD_DIM)
        k_c_c = _rmsnorm(kv_c_c[..., :GQA_KV_WIDTH].reshape(bn, ncx, GQA_KV_HEADS, HEAD_DIM), k_norm_g[l])
        v_c_c = kv_c_c[..., GQA_KV_WIDTH:].reshape(bn, ncx, GQA_KV_HEADS, HEAD_DIM)
        o_a = _neighbourhood_attn(q_a, k_a, v_a, k_a_c, v_a_c, na_rpb[l])
        o_b = _pool_mix(p_x[..., OFF_B_U:OFF_C_Q], pool_w[l], pool_scale[l])
        o_c = _gqa_blocks(q_c, jnp.concatenate([k_c, k_c_c], axis=1), jnp.concatenate([v_c, v_c_c], axis=1))
        h_x = h_x + mod_x[:, :, 5] * (jnp.concatenate([o_a, o_b, o_c], axis=-1) @ w_out[l])
        h_x = _half_ffn(h_x, norm_g[l, 2], mod_x[:, :, 6], mod_x[:, :, 7], mod_x[:, :, 8], ffn2_up[l], ffn2_down[l])
        if not last:
            q_a_c = (a_c @ w_in[l][:, OFF_A_Q:OFF_A_K]).reshape(bn, ncx, NA_HEADS, 1, HEAD_DIM)
            u_c = a_c @ w_in[l][:, OFF_B_U:OFF_C_Q]
            q_c_c = _rmsnorm((a_c @ w_in[l][:, OFF_C_Q:OFF_C_K]).reshape(bn, ncx, GQA_Q_HEADS, HEAD_DIM), q_norm_g[l])
            q_c_c = q_c_c.reshape(bn, ncx, GQA_KV_HEADS, GQA_GROUP, HEAD_DIM)
            oa_c = _gqa_attend(q_a_c, k_a_c, v_a_c).reshape(bn, ncx, NA_WIDTH)
            ob_c = _pool_mix(u_c, pool_w[l], pool_scale[l])
            oc_c = _gqa_attend(q_c_c, k_c_c, v_c_c).reshape(bn, ncx, GQA_Q_WIDTH)
            h_c = h_c + mod_c[:, :, 5] * (jnp.concatenate([oa_c, ob_c, oc_c], axis=-1) @ w_out[l])
            h_c = _half_ffn(h_c, norm_g[l, 2], mod_c[:, :, 6], mod_c[:, :, 7], mod_c[:, :, 8], ffn2_up[l], ffn2_down[l])
    return _rmsnorm(h_x, final_g)
```

```cpp
#include <hip/hip_runtime.h>
#include <hip/hip_cooperative_groups.h>
#include <cstdio>
namespace cg = cooperative_groups;

#ifndef MULTI
#define MULTI 0
#endif
#ifndef PROBE_DUP
#define PROBE_DUP 0
#endif

typedef unsigned short u16;
typedef __bf16 bf2_t __attribute__((ext_vector_type(2)));
typedef float f2_t __attribute__((ext_vector_type(2)));
using bf16x8 = __attribute__((ext_vector_type(8))) short;
using f32x4 = __attribute__((ext_vector_type(4))) float;
using f32x16 = __attribute__((ext_vector_type(16))) float;
using u32x4 = __attribute__((ext_vector_type(4))) unsigned;
using u32x2 = __attribute__((ext_vector_type(2))) unsigned;

#define DI __device__ __forceinline__
#define LAUNDER_V(x) asm volatile("" : "+v"(x))
#define LAUNDER_S(x) asm volatile("" : "+s"(x))
DI int get_tid(int wv) {
  int t; const int wb = wv << 6;
  asm volatile("v_mbcnt_lo_u32_b32 %0, -1, 0\n\tv_mbcnt_hi_u32_b32 %0, -1, %0\n\tv_or_b32 %0, %1, %0" : "=&v"(t) : "s"(wb));
  return t;
}
DI float shx(float v, int mask, int lane) { return __int_as_float(__builtin_amdgcn_ds_bpermute((lane ^ mask) << 2, __float_as_int(v))); }
DI int get_bid() { int b = blockIdx.x; LAUNDER_S(b); return b; }

DI unsigned pk2(float a, float b) { f2_t v = {a, b}; bf2_t r = __builtin_convertvector(v, bf2_t); return __builtin_bit_cast(unsigned, r); }
DI u16 f2bf(float a) { return (u16)(pk2(a, 0.f) & 0xffffu); }
DI float bf_lo(unsigned u) { return __uint_as_float(u << 16); }
DI float bf_hi(unsigned u) { return __uint_as_float(u & 0xffff0000u); }
DI float bf2f(u16 v) { return __uint_as_float(((unsigned)v) << 16); }

constexpr int DM = 1024, DFF = 2816, DIN = 1792, DEPTH = 4;
constexpr int M_LAT = 16384, M_CTX = 2048, M_ALL = 18432;
constexpr int NMOD = 9216;
constexpr int VT_LD = 2304;

constexpr size_t al256(size_t x) { return (x + 255) & ~(size_t)255; }
constexpr size_t WS_ROPE = 0;
constexpr size_t WS_MOD = 8192;
constexpr size_t MOD_BYTES = (size_t)DEPTH * 9 * NMOD * 4;
constexpr size_t WS_WT = al256(WS_MOD + MOD_BYTES);
constexpr size_t WT_UP = (size_t)5632 * 1024, WT_DN = (size_t)1024 * 2816, WT_IN = (size_t)1792 * 1024, WT_OUT = (size_t)1024 * 1024;
constexpr size_t WT_LAYER = 2 * WT_UP + 2 * WT_DN + WT_IN + WT_OUT;
constexpr size_t WS_H = al256(WS_WT + WT_LAYER * DEPTH * 2);
constexpr size_t WS_A = WS_H + (size_t)M_ALL * 1024 * 4;
constexpr size_t WS_X = WS_A + (size_t)M_ALL * 1024 * 2;
constexpr size_t WS_ACT = WS_X;
constexpr size_t WS_P = WS_X;
constexpr size_t WS_MIX = WS_P + (size_t)M_ALL * DIN * 2;
constexpr size_t IMG_TILE = 8192;
constexpr size_t WS_KA = WS_MIX + (size_t)M_ALL * 1024 * 2;
constexpr size_t WS_VA = WS_KA + (size_t)8 * 4 * 36 * IMG_TILE;
constexpr size_t WS_KC = WS_VA + (size_t)8 * 4 * 36 * IMG_TILE;
constexpr size_t WS_VC = WS_KC + (size_t)8 * 2 * 36 * IMG_TILE;
constexpr size_t WS_END1 = WS_X + (size_t)M_ALL * DFF * 2;
constexpr size_t WS_END2 = WS_VC + (size_t)8 * 2 * 36 * IMG_TILE;
constexpr size_t WS_END = WS_END1 > WS_END2 ? WS_END1 : WS_END2;

constexpr size_t WS_SW = al256(WS_END);
constexpr size_t SW_LD = 5632;
constexpr size_t WS_SSP = WS_SW + (size_t)DEPTH * 3 * 9 * SW_LD * 4;
constexpr size_t WS_SSPC = WS_SSP + (size_t)M_ALL * 4 * 4;
constexpr size_t WS_BAR = al256(WS_SSPC + (size_t)M_CTX * 8 * 4);
constexpr size_t BAR_BYTES = 16384;
constexpr size_t WS_PROBE = WS_BAR + BAR_BYTES;
constexpr size_t WS_TOTAL = WS_BAR + BAR_BYTES;
constexpr int LDS_MAIN = 147456;
constexpr int LDS_SSL = LDS_MAIN + 64;
constexpr int LDS_RL = LDS_SSL + 4096;
constexpr int LDS_PF = LDS_RL + 1024;
constexpr int LDS_BYTES = LDS_PF + 256;
constexpr int NPH = 3 + DEPTH * 7;

struct Params {
  const float *x, *c, *ctx, *c_ctx, *w_ada, *b_ada, *norm_g, *ffn1_up, *ffn1_down, *ffn2_up, *ffn2_down,
      *w_in, *w_out, *na_rpb, *pool_w, *pool_scale, *q_norm_g, *k_norm_g, *final_g;
  float* out;
  unsigned char* ws;
  int ph_lo, ph_hi;
};

constexpr int HT = 128 * 64;

DI int lds_byte(int r, int c) {
  int st = (r >> 4) * 2 + (c >> 5), rr = r & 15, cc = c & 31, ob = rr * 64 + cc * 2;
  return st * 1024 + (ob ^ (((ob >> 9) & 1) << 5));
}
DI void stage_rc(int b, int& R, int& C) {
  int st = b / 1024, sb = b % 1024, swz = sb ^ (((sb >> 9) & 1) << 5);
  R = (st >> 1) * 16 + swz / 64; C = (st & 1) * 32 + (swz % 64) / 2;
}

template <int K, bool HALFM, class Epi>
DI void gemm_tile(unsigned char* lds, const int tid, const u16* __restrict__ A, const u16* __restrict__ Bt, int brow, int bcol, Epi& epi,
                  const bool prefetched, const bool has_next, const int nbrow, const int nbcol) {
  u16* shm = (u16*)lds;
#define SA(b, h) (shm + ((b) * 2 + (h)) * HT)
#define SB(b, h) (shm + (4 + (b) * 2 + (h)) * HT)
#define STAGE(P, BASE, br, kt) do { const char* _gb = (const char*)(BASE) + ((size_t)(br) * (size_t)K + (size_t)(kt) * 64) * 2; \
    const unsigned _m0 = ldsw + (unsigned)((const char*)(P) - (const char*)shm); \
    asm volatile("s_mov_b32 m0, %0\n\ts_nop 0\n\tglobal_load_lds_dwordx4 %2, %4\n\ts_mov_b32 m0, %1\n\ts_nop 0\n\tglobal_load_lds_dwordx4 %3, %4" \
                 :: "s"(_m0), "s"(_m0 + 8192u), "v"(voff0), "v"(voff1), "s"(_gb) : "m0", "memory"); } while (0)
#define LDA(dst, b, h) for (int m = 0; m < 4; ++m) for (int k = 0; k < 2; ++k) \
    dst[m][k] = *reinterpret_cast<const bf16x8*>((char*)SA(b, h) + lds_byte(wr * 64 + m * 16 + fr, k * 32 + fq * 8))
#define LDB(dst, b, h) for (int n = 0; n < 2; ++n) for (int k = 0; k < 2; ++k) \
    dst[n][k] = *reinterpret_cast<const bf16x8*>((char*)SB(b, h) + lds_byte(wc * 32 + n * 16 + fr, k * 32 + fq * 8))
#define MMA(ai, bj, At_, Bt_) do { __builtin_amdgcn_s_setprio(1); \
    for (int m = 0; m < 4; ++m) for (int n = 0; n < 2; ++n) for (int k = 0; k < 2; ++k) \
      acc[ai][bj][m][n] = __builtin_amdgcn_mfma_f32_16x16x32_bf16(Bt_[n][k], At_[m][k], acc[ai][bj][m][n], 0, 0, 0); \
    __builtin_amdgcn_s_setprio(0); } while (0)
#define MMA_H(ai, bj, At_, Bt_) do { if (!HALFM) MMA(ai, bj, At_, Bt_); } while (0)
#define WAIT_V(n) asm volatile("s_waitcnt vmcnt(" #n ")" ::: "memory")
#define WAIT_L(n) asm volatile("s_waitcnt lgkmcnt(" #n ")" ::: "memory")
#define BAR __builtin_amdgcn_s_barrier()
#define SCHED __builtin_amdgcn_sched_barrier(0)
  constexpr int HALF = 128;
  constexpr int AH = HALFM ? 0 : HALF;
  const int tid16 = tid * 16;
  const unsigned ldsw = (unsigned)__builtin_amdgcn_readfirstlane((int)(((unsigned)(size_t)lds) + (unsigned)(tid >> 6) * 1024u));
  unsigned voff0, voff1;
  { int r_, c_; stage_rc(tid16, r_, c_); voff0 = (unsigned)(r_ * K + c_) * 2u;
    stage_rc(tid16 + 8192, r_, c_); voff1 = (unsigned)(r_ * K + c_) * 2u; }
  const int wid = tid >> 6, lane = tid & 63, wr = wid >> 2, wc = wid & 3, fr = lane & 15, fq = lane >> 4;
  f32x4 acc[2][2][4][2];
#pragma unroll
  for (int a = 0; a < 2; ++a)
#pragma unroll
    for (int b = 0; b < 2; ++b)
#pragma unroll
      for (int m = 0; m < 4; ++m)
#pragma unroll
        for (int n = 0; n < 2; ++n) acc[a][b][m][n] = (f32x4){0.f, 0.f, 0.f, 0.f};
  bf16x8 At[4][2], B0[2][2], B1[2][2];
  const int nt = K / 64;
  {
    const char* pfb = (const char*)epi.prefetch_base(brow, bcol);
    if (pfb) {
      const unsigned pm0 = (unsigned)__builtin_amdgcn_readfirstlane((int)((unsigned)(size_t)lds + LDS_PF));
#pragma unroll
      for (int i = 0; i < 4; ++i) {
        const int li = tid + i * 512;
        const unsigned vo = (unsigned)((li >> 3) * DM * 4 + (li & 7) * 128);
        asm volatile("s_mov_b32 m0, %0\n\ts_nop 0\n\tglobal_load_lds_dword %1, %2" :: "s"(pm0), "v"(vo), "s"(pfb) : "m0", "memory");
      }
    }
  }
  const float4 pre_v = epi.pre_load(tid, brow);
  if (!prefetched) {
    STAGE(SB(0, 0), Bt, bcol, 0); STAGE(SA(0, 0), A, brow, 0);
    STAGE(SB(0, 1), Bt, bcol + HALF, 0); STAGE(SA(0, 1), A, brow + AH, 0);
  }
  if (wr == 1) BAR;
  if (!prefetched) WAIT_V(4);
  BAR;
  epi.pre_use(pre_v, tid, lds);
  if (!prefetched) {
    STAGE(SB(1, 0), Bt, bcol, 1); STAGE(SA(1, 0), A, brow, 1); STAGE(SB(1, 1), Bt, bcol + HALF, 1);
    WAIT_V(6);
  }
  BAR;
  for (int t = 0; t < nt - 2; t += 2) {
    LDB(B0, 0, 0); SCHED; LDA(At, 0, 0); STAGE(SA(1, 1), A, brow + AH, t + 1);
    WAIT_L(8); BAR; WAIT_L(0); MMA(0, 0, At, B0); BAR; SCHED;
    LDB(B1, 0, 1); STAGE(SB(0, 0), Bt, bcol, t + 2);
    BAR; WAIT_L(0); MMA(0, 1, At, B1); BAR;
    if (!HALFM) { LDA(At, 0, 1); } STAGE(SA(0, 0), A, brow, t + 2);
    BAR; WAIT_L(0); MMA_H(1, 0, At, B0); BAR; SCHED;
    STAGE(SB(0, 1), Bt, bcol + HALF, t + 2);
    WAIT_V(6); BAR; MMA_H(1, 1, At, B1); BAR;
    LDB(B0, 1, 0); SCHED; LDA(At, 1, 0); STAGE(SA(0, 1), A, brow + AH, t + 2);
    WAIT_L(8); BAR; WAIT_L(0); MMA(0, 0, At, B0); BAR; SCHED;
    LDB(B1, 1, 1); STAGE(SB(1, 0), Bt, bcol, t + 3);
    BAR; WAIT_L(0); MMA(0, 1, At, B1); BAR;
    if (!HALFM) { LDA(At, 1, 1); } STAGE(SA(1, 0), A, brow, t + 3);
    BAR; WAIT_L(0); MMA_H(1, 0, At, B0); BAR; SCHED;
    STAGE(SB(1, 1), Bt, bcol + HALF, t + 3);
    WAIT_V(6); BAR; MMA_H(1, 1, At, B1); BAR;
  }
  { LDB(B0, 0, 0); LDA(At, 0, 0); STAGE(SA(1, 1), A, brow + AH, nt - 1);
    BAR; WAIT_L(0); MMA(0, 0, At, B0); BAR;
    LDB(B1, 0, 1); BAR; WAIT_L(0); MMA(0, 1, At, B1); BAR;
    if (!HALFM) { LDA(At, 0, 1); } WAIT_V(4); BAR; WAIT_L(0); MMA_H(1, 0, At, B0); MMA_H(1, 1, At, B1); BAR; }
  { LDB(B0, 1, 0); LDA(At, 1, 0); WAIT_V(2); BAR; WAIT_L(0); MMA(0, 0, At, B0); BAR;
    LDB(B1, 1, 1); WAIT_V(0); BAR; WAIT_L(0); MMA(0, 1, At, B1); BAR;
    if (!HALFM) { LDA(At, 1, 1); } BAR; WAIT_L(0); MMA_H(1, 0, At, B0); MMA_H(1, 1, At, B1); BAR; }
  if (wr == 0) BAR;
  if (has_next) {
    STAGE(SB(0, 0), Bt, nbcol, 0); STAGE(SA(0, 0), A, nbrow, 0);
    STAGE(SB(0, 1), Bt, nbcol + HALF, 0); STAGE(SA(0, 1), A, nbrow + AH, 0);
    STAGE(SB(1, 0), Bt, nbcol, 1); STAGE(SA(1, 0), A, nbrow, 1); STAGE(SB(1, 1), Bt, nbcol + HALF, 1);
  }
  { int te = tid; LAUNDER_V(te); const int wid_ = te >> 6, lane_ = te & 63;
    epi(acc, brow, bcol, wid_ >> 2, wid_ & 3, lane_ & 15, lane_ >> 4, HALFM ? 1 : 2); }
  if (!epi.stores_last()) WAIT_V(0);
#undef SA
#undef SB
#undef STAGE
#undef LDA
#undef LDB
#undef MMA
#undef MMA_H
}

template <int K, class Epi>
DI void gemm_phase(unsigned char* lds, int wv, const u16* A, const u16* Bt, int M, int N, Epi& epi) {
  const int nM = M >> 8, nN = N >> 8, T = nM * nN;
  const int G = gridDim.x, b = get_bid(), nx = G >> 3;
  const int full = T / G, R = T - full * G;
  const bool half_tail = (R > 0) && (2 * R <= G) && epi.allow_half();
  const int Tmain = half_tail ? full * G : T;
  bool prefetched = false;
  for (int it = 0; it * G < Tmain; ++it) {
    const int L = ((G & 7) == 0) ? (it * 8 + (b & 7)) * nx + (b >> 3) : it * G + b;
    if (L < Tmain) {
      const int grp = L / (4 * nN), rem = L - grp * (4 * nN);
      const int gm = min(4, nM - grp * 4);
      const int pm = grp * 4 + rem % gm, pn = rem / gm;
      const int L2 = ((G & 7) == 0) ? ((it + 1) * 8 + (b & 7)) * nx + (b >> 3) : (it + 1) * G + b;
      const bool has_next = L2 < Tmain;
      int pm2 = 0, pn2 = 0;
      if (has_next) { const int grp2 = L2 / (4 * nN), rem2 = L2 - grp2 * (4 * nN); const int gm2 = min(4, nM - grp2 * 4); pm2 = grp2 * 4 + rem2 % gm2; pn2 = rem2 / gm2; }
      gemm_tile<K, false>(lds, get_tid(wv), A, Bt, pm * 256, pn * 256, epi, prefetched, has_next, pm2 * 256, pn2 * 256);
      prefetched = has_next;
    }
  }
  if (half_tail && b < 2 * R) {
    const int L = full * G + (b >> 1);
    const int grp = L / (4 * nN), rem = L - grp * (4 * nN);
    const int gm = min(4, nM - grp * 4);
    const int pm = grp * 4 + rem % gm, pn = rem / gm;
    gemm_tile<K, true>(lds, get_tid(wv), A, Bt, pm * 256 + (b & 1) * 128, pn * 256, epi, false, false, 0, 0);
  }
}

struct SmallEpi {
  const float* hin; float* hout; const float* gate; float coef;
  bool do_next; u16* hg; const float* gnext; const float* scnext; float* sspc; float* ssl;
};
template <int K>
DI void gemm_small_tile(unsigned char* lds, const int tid, const u16* __restrict__ A, const u16* __restrict__ Bt,
                        const int row0, const int col0, const SmallEpi& E) {
  const int wave = tid >> 6, lane = tid & 63, ql = lane & 31, hl = lane >> 5;
  const int wm = wave >> 2, wn = wave & 3;
  constexpr int NT = K / 64;
  const int grow = tid >> 3, gc = (tid & 7) ^ ((grow >> 1) & 7);
  const unsigned voff = (unsigned)(grow * K + gc * 8) * 2u;
  const char* ga = (const char*)(A + (size_t)row0 * K) + voff;
  const char* gb = (const char*)(Bt + (size_t)col0 * K) + voff;
  unsigned char* ldst = lds + tid * 16;
#define SM_LOAD(t_, st_) do { \
    __builtin_amdgcn_global_load_lds((const unsigned*)(ga + (size_t)(t_) * 128), (unsigned*)(ldst + (st_) * 24576), 16, 0, 0); \
    __builtin_amdgcn_global_load_lds((const unsigned*)(gb + (size_t)(t_) * 128), (unsigned*)(ldst + (st_) * 24576 + 8192), 16, 0, 0); \
    __builtin_amdgcn_global_load_lds((const unsigned*)(gb + (size_t)64 * K * 2 + (size_t)(t_) * 128), (unsigned*)(ldst + (st_) * 24576 + 16384), 16, 0, 0); } while (0)
  SM_LOAD(0, 0); SM_LOAD(1, 1); SM_LOAD(2, 2); SM_LOAD(3, 3); SM_LOAD(4, 4);
  f32x16 acc;
#pragma unroll
  for (int i = 0; i < 16; ++i) acc[i] = 0.f;
  const int swk = (ql >> 1) & 7;
  const int aoff = (wm * 32 + ql) * 128, boff = 8192 + (wn * 32 + ql) * 128;
  int stc = 0, stl = 5;
  for (int t = 0; t < NT; ++t) {
    if (t + 4 < NT) asm volatile("s_waitcnt vmcnt(12)" ::: "memory");
    else if (t + 3 < NT) asm volatile("s_waitcnt vmcnt(9)" ::: "memory");
    else if (t + 2 < NT) asm volatile("s_waitcnt vmcnt(6)" ::: "memory");
    else if (t + 1 < NT) asm volatile("s_waitcnt vmcnt(3)" ::: "memory");
    else asm volatile("s_waitcnt vmcnt(0)" ::: "memory");
    __builtin_amdgcn_s_barrier();
    if (t + 5 < NT) SM_LOAD(t + 5, stl);
    const unsigned char* st = lds + stc * 24576;
    stc = (stc == 5) ? 0 : stc + 1; stl = (stl == 5) ? 0 : stl + 1;
#pragma unroll
    for (int ks = 0; ks < 4; ++ks) {
      const bf16x8 af = *(const bf16x8*)(st + aoff + (((ks * 2 + hl) ^ swk) << 4));
      const bf16x8 bf = *(const bf16x8*)(st + boff + (((ks * 2 + hl) ^ swk) << 4));
      acc = __builtin_amdgcn_mfma_f32_32x32x16_bf16(af, bf, acc, 0, 0, 0);
    }
  }
#undef SM_LOAD
  const int col = col0 + wn * 32 + ql;
  const float gv = E.gate[col] * E.coef;
  const float gm = E.do_next ? E.gnext[col] * (1.f + E.scnext[col]) : 0.f;
  float hv[16];
#pragma unroll
  for (int i = 0; i < 16; ++i) {
    const int row = row0 + wm * 32 + 8 * (i >> 2) + 4 * hl + (i & 3);
    hv[i] = E.hin[(size_t)row * DM + col];
  }
#pragma unroll
  for (int i = 0; i < 16; ++i) {
    const int rloc = wm * 32 + 8 * (i >> 2) + 4 * hl + (i & 3);
    const size_t o = (size_t)(row0 + rloc) * DM + col;
    const float hn = hv[i] + gv * acc[i];
    E.hout[o] = hn;
    if (E.do_next) {
      E.hg[o] = f2bf(hn * gm);
      float sq = hn * hn;
      sq += shx(sq, 1, lane); sq += shx(sq, 2, lane); sq += shx(sq, 4, lane); sq += shx(sq, 8, lane); sq += shx(sq, 16, lane);
      if (ql == 0) E.ssl[wn * 64 + rloc] = sq;
    }
  }
  if (E.do_next) {
    __syncthreads();
    if (tid < 64) E.sspc[(size_t)(row0 - M_LAT + tid) * 8 + (col0 >> 7)] = (E.ssl[tid] + E.ssl[64 + tid]) + (E.ssl[128 + tid] + E.ssl[192 + tid]);
  }
  asm volatile("s_waitcnt vmcnt(0)" ::: "memory");
  __builtin_amdgcn_s_barrier();
}

DI float4 ld4(const float* p) { return *(const float4*)p; }
DI float silu_mul(float a, float b) { return a * b * __builtin_amdgcn_rcpf(1.f + __builtin_amdgcn_exp2f(a * -1.4426950408889634f)); }


DI void store_nn16(u16* __restrict__ blk0, const u32x2 a, const u32x2 b, const int fq) {
  const auto s0 = __builtin_amdgcn_permlane16_swap(a[0], b[0], false, false);
  const auto s1 = __builtin_amdgcn_permlane16_swap(a[1], b[1], false, false);
  u32x4 v; v[0] = s0[0]; v[1] = s1[0]; v[2] = s0[1]; v[3] = s1[1];
  *(u32x4*)(blk0 + (fq & 1) * 16 + (fq >> 1) * 8) = v;
}
struct EpiSwiglu {
  static constexpr bool SL = true;
  u16* act;
  const float* ssp;
  const float* sw;
  const float* rl;
  bool ctx8;
  DI bool allow_half() const { return true; }
  DI bool stores_last() const { return SL; }
  DI const float* prefetch_base(int, int) const { return nullptr; }
  DI float4 pre_load(int tid, int brow) const {
    if (brow < M_LAT || !ctx8) return *(const float4*)(ssp + (size_t)(brow + (tid & 255)) * 4);
    const float* q_ = ssp + (size_t)M_ALL * 4 + (size_t)(brow - M_LAT + (tid & 255)) * 8;
    const float4 a_ = *(const float4*)q_, b_ = *(const float4*)(q_ + 4);
    return make_float4(a_.x + b_.x, a_.y + b_.y, a_.z + b_.z, a_.w + b_.w);
  }
  DI void pre_use(const float4& pp, int tid, unsigned char* lds) const {
    if (tid < 256) ((float*)(lds + LDS_RL))[tid] = rsqrtf((pp.x + pp.y + pp.z + pp.w) * (1.f / 1024.f) + 1e-6f);
  }
  DI void operator()(f32x4 (&acc)[2][2][4][2], int brow, int bcol, int wr, int wc, int fr, int fq, const int nai) const {
    const int bi = brow < M_LAT ? (brow >> 11) : 8;
    const float* swr = sw + bi * SW_LD + bcol + wc * 32 + fq * 4;
    const float4 sa0 = ld4(swr), sa1 = ld4(swr + 16), sb0 = ld4(swr + 128), sb1 = ld4(swr + 144);
    u16* ob = act + (size_t)(brow + wr * 64 + fr) * DFF + (bcol >> 1) + wc * 32 + (fq & 1) * 16 + (fq >> 1) * 8;
    u32x4 outv[2][4];
#pragma unroll
    for (int ai = 0; ai < 2; ++ai)
     if (ai < nai)
#pragma unroll
      for (int m = 0; m < 4; ++m) {
        const float r = rl[ai * 128 + wr * 64 + m * 16 + fr];
        u32x2 p0, p1;
        {
          const f32x4 a = acc[ai][0][m][0], b = acc[ai][1][m][0];
          p0[0] = pk2(silu_mul(a[0] * r + sa0.x, b[0] * r + sb0.x), silu_mul(a[1] * r + sa0.y, b[1] * r + sb0.y));
          p0[1] = pk2(silu_mul(a[2] * r + sa0.z, b[2] * r + sb0.z), silu_mul(a[3] * r + sa0.w, b[3] * r + sb0.w));
        }
        {
          const f32x4 a = acc[ai][0][m][1], b = acc[ai][1][m][1];
          p1[0] = pk2(silu_mul(a[0] * r + sa1.x, b[0] * r + sb1.x), silu_mul(a[1] * r + sa1.y, b[1] * r + sb1.y));
          p1[1] = pk2(silu_mul(a[2] * r + sa1.z, b[2] * r + sb1.z), silu_mul(a[3] * r + sa1.w, b[3] * r + sb1.w));
        }
        const auto s0 = __builtin_amdgcn_permlane16_swap(p0[0], p1[0], false, false);
        const auto s1 = __builtin_amdgcn_permlane16_swap(p0[1], p1[1], false, false);
        outv[ai][m][0] = s0[0]; outv[ai][m][1] = s1[0]; outv[ai][m][2] = s0[1]; outv[ai][m][3] = s1[1];
      }
    asm volatile("s_waitcnt vmcnt(0)" ::: "memory");
#pragma unroll
    for (int ai = 0; ai < 2; ++ai)
     if (ai < nai)
#pragma unroll
      for (int m = 0; m < 4; ++m) *(u32x4*)(ob + (size_t)(ai * 128 + m * 16) * DFF) = outv[ai][m];
  }
};

struct EpiBf16 {
  static constexpr bool SL = false;
  u16* out; int ld;
  const float* ssp;
  const float* sw;
  const float* rl;
  bool ctx8;
  DI bool allow_half() const { return true; }
  DI bool stores_last() const { return SL; }
  DI const float* prefetch_base(int, int) const { return nullptr; }
  DI float4 pre_load(int tid, int brow) const {
    if (brow < M_LAT || !ctx8) return *(const float4*)(ssp + (size_t)(brow + (tid & 255)) * 4);
    const float* q_ = ssp + (size_t)M_ALL * 4 + (size_t)(brow - M_LAT + (tid & 255)) * 8;
    const float4 a_ = *(const float4*)q_, b_ = *(const float4*)(q_ + 4);
    return make_float4(a_.x + b_.x, a_.y + b_.y, a_.z + b_.z, a_.w + b_.w);
  }
  DI void pre_use(const float4& pp, int tid, unsigned char* lds) const {
    if (tid < 256) ((float*)(lds + LDS_RL))[tid] = rsqrtf((pp.x + pp.y + pp.z + pp.w) * (1.f / 1024.f) + 1e-6f);
  }
  DI void operator()(f32x4 (&acc)[2][2][4][2], int brow, int bcol, int wr, int wc, int fr, int fq, const int nai) const {
    const int bi = brow < M_LAT ? (brow >> 11) : 8;
    const float* swr = sw + bi * SW_LD + bcol + wc * 32 + fq * 4;
    float4 sv[2][2];
    sv[0][0] = ld4(swr); sv[0][1] = ld4(swr + 16); sv[1][0] = ld4(swr + 128); sv[1][1] = ld4(swr + 144);
    u16* ob = out + (size_t)(brow + wr * 64 + fr) * ld + bcol + wc * 32 + fq * 4;
#pragma unroll
    for (int ai = 0; ai < 2; ++ai)
     if (ai < nai)
#pragma unroll
      for (int m = 0; m < 4; ++m) {
        const float r = rl[ai * 128 + wr * 64 + m * 16 + fr];
        u16* o_ = ob + (size_t)(ai * 128 + m * 16) * ld;
#pragma unroll
        for (int bj = 0; bj < 2; ++bj)
#pragma unroll
          for (int n = 0; n < 2; ++n) {
            const f32x4 a = acc[ai][bj][m][n];
            const float4 s4 = sv[bj][n];
            u32x2 pk; pk[0] = pk2(a[0] * r + s4.x, a[1] * r + s4.y); pk[1] = pk2(a[2] * r + s4.z, a[3] * r + s4.w);
            *(u32x2*)(o_ + bj * 128 + n * 16) = pk;
          }
      }
  }
};


DI void store_kimg16(unsigned char* __restrict__ rowp, const u32x2 a, const u32x2 b, const int fq, const int cbase, const int swz) {
  const auto s0 = __builtin_amdgcn_permlane16_swap(a[0], b[0], false, false);
  const auto s1 = __builtin_amdgcn_permlane16_swap(a[1], b[1], false, false);
  u32x4 v; v[0] = s0[0]; v[1] = s1[0]; v[2] = s0[1]; v[3] = s1[1];
  const int chunk = cbase + (fq & 1) * 2 + (fq >> 1);
  *(u32x4*)(rowp + ((chunk ^ swz) << 4)) = v;
}
struct EpiProj {
  u16* out; int ld;
  const float* ssp;
  const float* sw;
  const float* rl;
  bool ctx8;
  unsigned char* ws;
  const float* kg;
  const float* tab;
  float* ssl;
  DI bool allow_half() const { return false; }
  DI bool stores_last() const { return false; }
  DI const float* prefetch_base(int, int) const { return nullptr; }
  DI float4 pre_load(int tid, int brow) const {
    if (brow < M_LAT || !ctx8) return *(const float4*)(ssp + (size_t)(brow + (tid & 255)) * 4);
    const float* q_ = ssp + (size_t)M_ALL * 4 + (size_t)(brow - M_LAT + (tid & 255)) * 8;
    const float4 a_ = *(const float4*)q_, b_ = *(const float4*)(q_ + 4);
    return make_float4(a_.x + b_.x, a_.y + b_.y, a_.z + b_.z, a_.w + b_.w);
  }
  DI void pre_use(const float4& pp, int tid, unsigned char* lds) const {
    if (tid < 256) ((float*)(lds + LDS_RL))[tid] = rsqrtf((pp.x + pp.y + pp.z + pp.w) * (1.f / 1024.f) + 1e-6f);
  }
  DI void keyof(int row, int& b, int& keypos) const {
    if (row < M_LAT) { b = row >> 11; keypos = row & 2047; } else { const int rc = row - M_LAT; b = rc >> 8; keypos = 2048 + (rc & 255); }
  }
  DI void operator()(f32x4 (&acc)[2][2][4][2], int brow, int bcol, int wr, int wc, int fr, int fq, const int nai) const {
    const int bi = brow < M_LAT ? (brow >> 11) : 8;
    const int pn = bcol >> 8;
    const int lane = fq * 16 + fr;
    const float* swr = sw + bi * SW_LD + bcol + wc * 32 + fq * 4;
    float4 sv[2][2];
    sv[0][0] = ld4(swr); sv[0][1] = ld4(swr + 16); sv[1][0] = ld4(swr + 128); sv[1][1] = ld4(swr + 144);
#pragma unroll
    for (int ai = 0; ai < 2; ++ai)
#pragma unroll
      for (int m = 0; m < 4; ++m) {
        const float r = rl[ai * 128 + wr * 64 + m * 16 + fr];
#pragma unroll
        for (int bj = 0; bj < 2; ++bj)
#pragma unroll
          for (int n = 0; n < 2; ++n) {
            f32x4 a = acc[ai][bj][m][n];
            const float4 s4 = sv[bj][n];
            a[0] = a[0] * r + s4.x; a[1] = a[1] * r + s4.y; a[2] = a[2] * r + s4.z; a[3] = a[3] * r + s4.w;
            acc[ai][bj][m][n] = a;
          }
      }
    if (pn == 0 || (pn >= 3 && pn <= 5)) {
      u16* ob = out + (size_t)(brow + wr * 64 + fr) * ld + bcol + wc * 32;
#pragma unroll
      for (int ai = 0; ai < 2; ++ai)
#pragma unroll
        for (int m = 0; m < 4; ++m)
#pragma unroll
          for (int bj = 0; bj < 2; ++bj) {
            const f32x4 a = acc[ai][bj][m][0], b = acc[ai][bj][m][1];
            u32x2 p0, p1; p0[0] = pk2(a[0], a[1]); p0[1] = pk2(a[2], a[3]); p1[0] = pk2(b[0], b[1]); p1[1] = pk2(b[2], b[3]);
            store_nn16(ob + (size_t)(ai * 128 + m * 16) * ld + bj * 128, p0, p1, fq);
          }
      return;
    }
    const int hsub = wc >> 1;
    const int dbase = (wc & 1) * 32 + fq * 4;
    if (pn == 6) {
#pragma unroll
      for (int ai = 0; ai < 2; ++ai)
#pragma unroll
        for (int m = 0; m < 4; ++m) {
          const f32x4 a0 = acc[ai][0][m][0], a1 = acc[ai][0][m][1];
          float sq = a0[0] * a0[0] + a0[1] * a0[1] + a0[2] * a0[2] + a0[3] * a0[3] + a1[0] * a1[0] + a1[1] * a1[1] + a1[2] * a1[2] + a1[3] * a1[3];
          sq += shx(sq, 16, lane); sq += shx(sq, 32, lane);
          if (fq == 0) ssl[wc * 256 + ai * 128 + wr * 64 + m * 16 + fr] = sq;
        }
      __syncthreads();
      const float4 g0 = ld4(kg + dbase), g1 = ld4(kg + dbase + 16);
#pragma unroll
      for (int ai = 0; ai < 2; ++ai)
#pragma unroll
        for (int m = 0; m < 4; ++m) {
          const int rloc = ai * 128 + wr * 64 + m * 16 + fr;
          const int row = brow + rloc;
          const float rs = rsqrtf((ssl[wc * 256 + rloc] + ssl[(wc ^ 1) * 256 + rloc]) * (1.f / 64.f) + 1e-6f);
          f32x4 y1 = acc[ai][0][m][0], y2 = acc[ai][0][m][1];
          y1[0] *= rs * g0.x; y1[1] *= rs * g0.y; y1[2] *= rs * g0.z; y1[3] *= rs * g0.w;
          y2[0] *= rs * g1.x; y2[1] *= rs * g1.y; y2[2] *= rs * g1.z; y2[3] *= rs * g1.w;
          if (row < M_LAT) {
            const int pos = row & 2047;
            const float* tp = tab + (((wc & 1) ? (pos & 63) : (pos >> 6)) * 16 + fq * 4) * 2;
            const float4 c01 = ld4(tp), c23 = ld4(tp + 4);
            float t_;
            t_ = y1[0] * c01.x - y2[0] * c01.y; y2[0] = y1[0] * c01.y + y2[0] * c01.x; y1[0] = t_;
            t_ = y1[1] * c01.z - y2[1] * c01.w; y2[1] = y1[1] * c01.w + y2[1] * c01.z; y1[1] = t_;
            t_ = y1[2] * c23.x - y2[2] * c23.y; y2[2] = y1[2] * c23.y + y2[2] * c23.x; y1[2] = t_;
            t_ = y1[3] * c23.z - y2[3] * c23.w; y2[3] = y1[3] * c23.w + y2[3] * c23.z; y1[3] = t_;
          }
          int b, keypos; keyof(row, b, keypos);
          const int key = keypos & 63, swz = (key >> 1) & 7;
          unsigned char* img = ws + WS_KC + ((size_t)((b * 2 + hsub) * 36 + (keypos >> 6))) * IMG_TILE + key * 128;
          u32x2 p1, p2; p1[0] = pk2(y1[0], y1[1]); p1[1] = pk2(y1[2], y1[3]); p2[0] = pk2(y2[0], y2[1]); p2[1] = pk2(y2[2], y2[3]);
          store_kimg16(img, p1, p2, fq, (wc & 1) * 4, swz);
        }
    }
    if (pn == 1) {
#pragma unroll
      for (int ai = 0; ai < 2; ++ai)
#pragma unroll
        for (int m = 0; m < 4; ++m) {
          const int row = brow + ai * 128 + wr * 64 + m * 16 + fr;
          int b, keypos; keyof(row, b, keypos);
          const int key = keypos & 63, swz = (key >> 1) & 7;
          const int c0 = (wc & 1) * 4 + (fq >> 1);
#pragma unroll
          for (int bj = 0; bj < 2; ++bj) {
            unsigned char* img = ws + WS_KA + ((size_t)((b * 4 + bj * 2 + hsub) * 36 + (keypos >> 6))) * IMG_TILE + key * 128;
            const f32x4 a = acc[ai][bj][m][0], bb_ = acc[ai][bj][m][1];
            u32x2 p0, p1; p0[0] = pk2(a[0], a[1]); p0[1] = pk2(a[2], a[3]); p1[0] = pk2(bb_[0], bb_[1]); p1[1] = pk2(bb_[2], bb_[3]);
            store_kimg16(img, p0, p1, fq, (wc & 1) * 4, swz);
          }
        }
    }
    if (pn == 2 || pn == 6) {
#pragma unroll
      for (int ai = 0; ai < 2; ++ai)
#pragma unroll
        for (int m = 0; m < 4; ++m) {
          const int row = brow + ai * 128 + wr * 64 + m * 16 + fr;
          int b, keypos; keyof(row, b, keypos);
          const int key = keypos & 63;
#pragma unroll
          for (int bj = 0; bj < 2; ++bj) {
            if (pn == 6 && bj == 0) continue;
            unsigned char* img = (pn == 2 ? ws + WS_VA + ((size_t)((b * 4 + bj * 2 + hsub) * 36 + (keypos >> 6))) * IMG_TILE
                                          : ws + WS_VC + ((size_t)((b * 2 + hsub) * 36 + (keypos >> 6))) * IMG_TILE) + (key & 7) * 2;
#pragma unroll
            for (int n = 0; n < 2; ++n) {
              const f32x4 a = acc[ai][bj][m][n];
#pragma unroll
              for (int j = 0; j < 4; ++j) {
                const int d = dbase + n * 16 + j;
                *(u16*)(img + d * 128 + ((((key >> 3)) ^ ((d >> 1) & 7)) << 4)) = f2bf(a[j]);
              }
            }
          }
        }
    }
  }
};

struct EpiResid {
  const float* hin_lat;
  const float* hin_ctx;
  float* hout;
  const float* gate;
  float coef;
  bool do_next;
  u16* hg;
  const float* gnext;
  const float* scnext;
  float* ssp;
  float* ssl;
  DI bool allow_half() const { return false; }
  DI bool stores_last() const { return false; }
  DI const float* prefetch_base(int brow, int bcol) const { return (brow < M_LAT ? hin_lat : hin_ctx - (size_t)M_LAT * DM) + (size_t)brow * DM + bcol; }
  DI float4 pre_load(int tid, int) const { const float z = (float)tid; return make_float4(z, z, z, z); }
  DI void pre_use(const float4&, int, unsigned char*) const {}
  DI void operator()(f32x4 (&acc)[2][2][4][2], int brow, int bcol, int wr, int wc, int fr, int fq, const int nai) const {
    const int bi = brow < M_LAT ? (brow >> 11) : 8;
    const float* hin = brow < M_LAT ? hin_lat : hin_ctx - (size_t)M_LAT * DM;
    const float* g = gate + bi * NMOD;
    const int lane = fq * 16 + fr;
    const int c0 = bcol + wc * 32 + fq * 4;
    float4 gv[2][2], gm[2][2];
#pragma unroll
    for (int bj = 0; bj < 2; ++bj)
#pragma unroll
      for (int n = 0; n < 2; ++n) {
        const int col = c0 + bj * 128 + n * 16;
        float4 t_ = ld4(g + col);
        gv[bj][n] = make_float4(t_.x * coef, t_.y * coef, t_.z * coef, t_.w * coef);
        if (do_next) {
          const float4 gg = ld4(gnext + col), sc = ld4(scnext + bi * NMOD + col);
          gm[bj][n] = make_float4(gg.x * (1.f + sc.x), gg.y * (1.f + sc.y), gg.z * (1.f + sc.z), gg.w * (1.f + sc.w));
        } else gm[bj][n] = gv[bj][n];
      }
#pragma unroll
    for (int aim = 0; aim < 4; ++aim) {
      const int ai = aim >> 1, mh = (aim & 1) * 2;
      float4 t[2][2][2];
#pragma unroll
      for (int m2 = 0; m2 < 2; ++m2) {
        const float* hi_ = hin + (size_t)(brow + ai * 128 + wr * 64 + (mh + m2) * 16 + fr) * DM + c0;
#pragma unroll
        for (int bj = 0; bj < 2; ++bj)
#pragma unroll
          for (int n = 0; n < 2; ++n) t[m2][bj][n] = ld4(hi_ + bj * 128 + n * 16);
      }
#pragma unroll
      for (int m2 = 0; m2 < 2; ++m2) {
        const int m = mh + m2;
        const int rloc = ai * 128 + wr * 64 + m * 16 + fr;
        float* ho_ = hout + (size_t)(brow + rloc) * DM + c0;
        u16* hg_ = hg + (size_t)(brow + rloc) * DM + bcol + wc * 32;
        u32x2 hpk[2];
        float sq = 0.f;
#pragma unroll
        for (int bj = 0; bj < 2; ++bj)
#pragma unroll
          for (int n = 0; n < 2; ++n) {
            const f32x4 a = acc[ai][bj][m][n];
            const float4 gvv = gv[bj][n];
            float4 hn = t[m2][bj][n];
            hn.x += gvv.x * a[0]; hn.y += gvv.y * a[1]; hn.z += gvv.z * a[2]; hn.w += gvv.w * a[3];
            *(float4*)(ho_ + bj * 128 + n * 16) = hn;
            if (do_next) {
              sq += hn.x * hn.x + hn.y * hn.y + hn.z * hn.z + hn.w * hn.w;
              const float4 gmm = gm[bj][n];
              hpk[n][0] = pk2(hn.x * gmm.x, hn.y * gmm.y); hpk[n][1] = pk2(hn.z * gmm.z, hn.w * gmm.w);
              if (n == 1) store_nn16(hg_ + bj * 128, hpk[0], hpk[1], fq);
            }
          }
        if (do_next) {
          sq += shx(sq, 16, lane); sq += shx(sq, 32, lane);
          if (fq == 0) ssl[wc * 256 + rloc] = sq;
        }
      }
      __builtin_amdgcn_sched_barrier(0);
    }
    if (do_next) {
      __syncthreads();
      const int tid_ = (wr * 4 + wc) * 64 + lane;
      if (tid_ < 256) ssp[(size_t)(brow + tid_) * 4 + (bcol >> 8)] = (ssl[tid_] + ssl[256 + tid_]) + (ssl[512 + tid_] + ssl[768 + tid_]);
    }
  }
};

DI void p0_transpose_item(const Params& P, unsigned char* lds, int l, int r, const int tid) {
  u16* wt = (u16*)(P.ws + WS_WT) + (size_t)l * WT_LAYER;
  const float* src; u16* dst; int K, N, perm = 0;
  if (r < 352) { src = P.ffn1_up + (size_t)l * 1024 * 5632; K = 1024; N = 5632; dst = wt; perm = 1; }
  else if (r < 528) { r -= 352; src = P.ffn1_down + (size_t)l * 2816 * 1024; K = 2816; N = 1024; dst = wt + WT_UP; }
  else if (r < 880) { r -= 528; src = P.ffn2_up + (size_t)l * 1024 * 5632; K = 1024; N = 5632; dst = wt + WT_UP + WT_DN; perm = 1; }
  else if (r < 1056) { r -= 880; src = P.ffn2_down + (size_t)l * 2816 * 1024; K = 2816; N = 1024; dst = wt + 2 * WT_UP + WT_DN; }
  else if (r < 1168) { r -= 1056; src = P.w_in + (size_t)l * 1024 * DIN; K = 1024; N = DIN; dst = wt + 2 * WT_UP + 2 * WT_DN; }
  else { r -= 1168; src = P.w_out + (size_t)l * 1024 * 1024; K = 1024; N = 1024; dst = wt + 2 * WT_UP + 2 * WT_DN + WT_IN; }
  const int nN = N >> 8;
  const int kt = r / nN, ntl = r - kt * nN;
  const int k0 = kt * 64, n0 = ntl * 256;
  float* T = (float*)lds;
  float4 v[8];
#pragma unroll
  for (int i = 0; i < 8; ++i) {
    const int idx = tid + i * 512, k = idx >> 6, n4 = idx & 63;
    v[i] = *(const float4*)(src + (size_t)(k0 + k) * N + n0 + n4 * 4);
  }
#pragma unroll
  for (int i = 0; i < 8; ++i) {
    const int idx = tid + i * 512, k = idx >> 6, n4 = idx & 63;
    *(float4*)(T + k * 260 + ((n4 ^ (k >> 3)) << 2)) = v[i];
  }
  __syncthreads();
#pragma unroll
  for (int i = 0; i < 4; ++i) {
    const int idx = tid + i * 512, n = idx >> 3, c = idx & 7;
    float e[8];
#pragma unroll
    for (int j = 0; j < 8; ++j) e[j] = T[(c * 8 + j) * 260 + ((((n >> 2) ^ c)) << 2) + (n & 3)];
    u32x4 o; o[0] = pk2(e[0], e[1]); o[1] = pk2(e[2], e[3]); o[2] = pk2(e[4], e[5]); o[3] = pk2(e[6], e[7]);
    const int ng = n0 + n;
    int drow = ng;
    if (perm) drow = (ng < DFF) ? ((ng >> 7) * 256 + (ng & 127)) : ((((ng - DFF) >> 7) * 256) + 128 + ((ng - DFF) & 127));
    *(u32x4*)(dst + (size_t)drow * K + k0 + c * 8) = o;
  }
  __syncthreads();
}

DI void p0_mod_item(const Params& P, unsigned char* lds, int idx, const int tid) {
  const int wave = tid >> 6, lane = tid & 63;
  const int l = idx / 36, cch = idx - l * 36;
  float* sl = (float*)lds;
  float* red = sl + 9 * 1024;
  for (int i = tid; i < 9 * 1024; i += 512) {
    int r = i >> 10, k = i & 1023;
    float cv = r < 8 ? P.c[r * 1024 + k] : P.c_ctx[k];
    sl[i] = cv / (1.f + expf(-cv));
  }
  __syncthreads();
  float4 acc[9];
#pragma unroll
  for (int r = 0; r < 9; ++r) acc[r] = make_float4(0.f, 0.f, 0.f, 0.f);
  const float* W = P.w_ada + ((size_t)l * 1024 + wave * 128) * NMOD + cch * 256 + lane * 4;
  for (int k4 = 0; k4 < 32; ++k4) {
    float4 w0 = *(const float4*)(W + (size_t)(k4 * 4 + 0) * NMOD);
    float4 w1 = *(const float4*)(W + (size_t)(k4 * 4 + 1) * NMOD);
    float4 w2 = *(const float4*)(W + (size_t)(k4 * 4 + 2) * NMOD);
    float4 w3 = *(const float4*)(W + (size_t)(k4 * 4 + 3) * NMOD);
#pragma unroll
    for (int r = 0; r < 9; ++r) {
      float4 s4 = *(const float4*)(sl + r * 1024 + wave * 128 + k4 * 4);
      acc[r].x += s4.x * w0.x + s4.y * w1.x + s4.z * w2.x + s4.w * w3.x;
      acc[r].y += s4.x * w0.y + s4.y * w1.y + s4.z * w2.y + s4.w * w3.y;
      acc[r].z += s4.x * w0.z + s4.y * w1.z + s4.z * w2.z + s4.w * w3.z;
      acc[r].w += s4.x * w0.w + s4.y * w1.w + s4.z * w2.w + s4.w * w3.w;
    }
  }
#pragma unroll
  for (int r = 0; r < 9; ++r) *(float4*)(red + (wave * 9 + r) * 256 + lane * 4) = acc[r];
  __syncthreads();
  float* mod = (float*)(P.ws + WS_MOD);
  for (int o = tid; o < 2304; o += 512) {
    int r = o >> 8, cc = o & 255;
    float sacc = P.b_ada[l * NMOD + cch * 256 + cc];
#pragma unroll
    for (int w = 0; w < 8; ++w) sacc += red[(w * 9 + r) * 256 + cc];
    mod[((size_t)l * 9 + r) * NMOD + cch * 256 + cc] = sacc;
  }
  __syncthreads();
}

DI void phase0(const Params& P, unsigned char* lds, int wv) {
  const int NMODI = 36, NTR = 1232;
  const int total = NMODI + NTR + 1;
  const int tid = get_tid(wv);
  for (int it = get_bid(); it < total; it += gridDim.x) {
    if (it < NMODI) p0_mod_item(P, lds, it, tid);
    else if (it < NMODI + NTR) p0_transpose_item(P, lds, 0, it - NMODI, tid);
    else {
      float* tab = (float*)(P.ws + WS_ROPE);
      for (int e = tid; e < 1024; e += 512) {
        int pos = e >> 4, i = e & 15;
        float inv = powf(10000.f, -(float)(2 * i) / 32.f);
        float ang = (float)pos * inv;
        tab[e * 2] = cosf(ang); tab[e * 2 + 1] = sinf(ang);
      }
    }
  }
}

DI float wave_sum(float v, int lane) {
#pragma unroll
  for (int o = 32; o >= 1; o >>= 1) v += shx(v, o, lane);
  return v;
}

DI void sw_item(const Params& P, unsigned char* lds, const int l, const int r, const int tid) {
  const int wave = tid >> 6, lane = tid & 63;
  const float* mod = (const float*)(P.ws + WS_MOD);
  u16* shl = (u16*)lds;
  const int ql = lane & 31, hl = lane >> 5;
  {
    int st, ch;
    if (r < 22) { st = 0; ch = r; } else if (r < 29) { st = 1; ch = r - 22; } else { st = 2; ch = r - 29; }
    const u16* wt = (const u16*)(P.ws + WS_WT) + (size_t)l * WT_LAYER + (st == 0 ? 0 : (st == 1 ? 2 * WT_UP + 2 * WT_DN : WT_UP + WT_DN));
    for (int i = tid; i < 9 * 1024; i += 512) {
      const float v = mod[((size_t)l * 9 + (i >> 10)) * NMOD + (st * 3) * 1024 + (i & 1023)];
      const u16 hi = f2bf(v);
      shl[(i >> 10) * 1032 + (i & 1023)] = hi;
      shl[9 * 1032 + (i >> 10) * 1032 + (i & 1023)] = f2bf(v - bf2f(hi));
    }
    __syncthreads();
    const int n0 = ch * 256 + wave * 32;
    const u16* wrow = wt + (size_t)(n0 + ql) * 1024 + hl * 8;
    f32x16 acc;
#pragma unroll
    for (int i = 0; i < 16; ++i) acc[i] = 0.f;
#pragma unroll 8
    for (int kk = 0; kk < 64; ++kk) {
      const bf16x8 aw = *(const bf16x8*)(wrow + kk * 16);
      bf16x8 bh = (bf16x8){0, 0, 0, 0, 0, 0, 0, 0}, bl = (bf16x8){0, 0, 0, 0, 0, 0, 0, 0};
      if (ql < 9) {
        bh = *(const bf16x8*)(shl + ql * 1032 + kk * 16 + hl * 8);
        bl = *(const bf16x8*)(shl + 9 * 1032 + ql * 1032 + kk * 16 + hl * 8);
      }
      acc = __builtin_amdgcn_mfma_f32_32x32x16_bf16(aw, bh, acc, 0, 0, 0);
      acc = __builtin_amdgcn_mfma_f32_32x32x16_bf16(aw, bl, acc, 0, 0, 0);
    }
    if (ql < 9) {
      float* swo = (float*)(P.ws + WS_SW) + ((size_t)(l * 3 + st) * 9 + ql) * SW_LD + n0 + hl * 4;
#pragma unroll
      for (int j = 0; j < 4; ++j) *(float4*)(swo + 8 * j) = make_float4(acc[4 * j], acc[4 * j + 1], acc[4 * j + 2], acc[4 * j + 3]);
    }
    __syncthreads();
  }
}

DI void phase0b(const Params& P, unsigned char* lds, int wv) {
  const int tid = get_tid(wv);
  const int wave = tid >> 6, lane = tid & 63;
  const int bid = get_bid(), G = gridDim.x;
  const float* mod = (const float*)(P.ws + WS_MOD);
  for (int it = bid; it < 51; it += G) sw_item(P, lds, 0, it, tid);
  u16* hg = (u16*)(P.ws + WS_A);
  float* ssp = (float*)(P.ws + WS_SSP);
  for (int row = bid * 8 + wave; row < M_ALL; row += G * 8) {
    const float* src = row < M_LAT ? P.x + (size_t)row * DM : P.ctx + (size_t)(row - M_LAT) * DM;
    const int bi = row < M_LAT ? (row >> 11) : 8;
    const float* sc = mod + bi * NMOD + 1024;
    float ss = 0.f;
#pragma unroll
    for (int i = 0; i < 4; ++i) {
      const int c = i * 256 + lane * 4;
      const float4 v = *(const float4*)(src + c);
      ss += v.x * v.x + v.y * v.y + v.z * v.z + v.w * v.w;
      const float4 gg = *(const float4*)(P.norm_g + c), s4 = *(const float4*)(sc + c);
      u32x2 o; o[0] = pk2(v.x * gg.x * (1.f + s4.x), v.y * gg.y * (1.f + s4.y)); o[1] = pk2(v.z * gg.z * (1.f + s4.z), v.w * gg.w * (1.f + s4.w));
      *(u32x2*)(hg + (size_t)row * DM + c) = o;
    }
    ss = wave_sum(ss, lane);
    if (lane == 0) {
      const float z = ss * 0.f;
      if (row < M_LAT) *(float4*)(ssp + (size_t)row * 4) = make_float4(ss, z, z, z);
      else { float* q_ = ssp + (size_t)M_ALL * 4 + (size_t)(row - M_LAT) * 8; *(float4*)q_ = make_float4(ss, z, z, z); *(float4*)(q_ + 4) = make_float4(z, z, z, z); }
    }
  }
}

DI void final_phase(const Params& P, int wv) {
  const int tid = get_tid(wv);
  const int wave = tid >> 6, lane = tid & 63;
  const float* h = (const float*)(P.ws + WS_H);
  for (int row = get_bid() * 8 + wave; row < M_LAT; row += gridDim.x * 8) {
    const float* src = h + (size_t)row * DM;
    float4 v[4]; float ss = 0.f;
#pragma unroll
    for (int i = 0; i < 4; ++i) {
      v[i] = *(const float4*)(src + i * 256 + lane * 4);
      ss += v[i].x * v[i].x + v[i].y * v[i].y + v[i].z * v[i].z + v[i].w * v[i].w;
    }
    ss = wave_sum(ss, lane);
    const float r = rsqrtf(ss * (1.f / 1024.f) + 1e-6f);
#pragma unroll
    for (int i = 0; i < 4; ++i) {
      int c = i * 256 + lane * 4;
      float4 gg = *(const float4*)(P.final_g + c);
      float4 o = make_float4(v[i].x * r * gg.x, v[i].y * r * gg.y, v[i].z * r * gg.z, v[i].w * r * gg.w);
      *(float4*)(P.out + (size_t)row * DM + c) = o;
    }
  }
}

DI void pp_normrope_one(u16* ptr, const float* __restrict__ g, bool rope, int pos, const float* __restrict__ tab, unsigned char* img, int swz) {
  float x[64];
#pragma unroll
  for (int i = 0; i < 8; ++i) {
    u32x4 raw = *(const u32x4*)(ptr + i * 8);
#pragma unroll
    for (int j = 0; j < 4; ++j) { x[i * 8 + 2 * j] = bf_lo(raw[j]); x[i * 8 + 2 * j + 1] = bf_hi(raw[j]); }
  }
  float ss = 0.f;
#pragma unroll
  for (int d = 0; d < 64; ++d) ss += x[d] * x[d];
  const float r = rsqrtf(ss * (1.f / 64.f) + 1e-6f);
#pragma unroll
  for (int d = 0; d < 64; ++d) x[d] = x[d] * r * g[d];
  if (rope) {
    const float2* tr = (const float2*)tab + (pos >> 6) * 16;
    const float2* tc = (const float2*)tab + (pos & 63) * 16;
#pragma unroll
    for (int i = 0; i < 16; ++i) {
      float2 cs = tr[i];
      float x1 = x[i], x2 = x[16 + i];
      x[i] = x1 * cs.x - x2 * cs.y; x[16 + i] = x1 * cs.y + x2 * cs.x;
      float2 cs2 = tc[i];
      float y1 = x[32 + i], y2 = x[48 + i];
      x[32 + i] = y1 * cs2.x - y2 * cs2.y; x[48 + i] = y1 * cs2.y + y2 * cs2.x;
    }
  }
#pragma unroll
  for (int i = 0; i < 8; ++i) {
    u32x4 o;
#pragma unroll
    for (int j = 0; j < 4; ++j) o[j] = pk2(x[i * 8 + 2 * j], x[i * 8 + 2 * j + 1]);
    *(u32x4*)(ptr + i * 8) = o;
    if (img) *(u32x4*)(img + ((i ^ swz) << 4)) = o;
  }
}

DI void pool_item(const Params& P, unsigned char* lds, const int l, const int tt, const int tid) {
  const u16* p = (const u16*)(P.ws + WS_P);
  u16* mix = (u16*)(P.ws + WS_MIX);
  const int row0 = tt * 64;
  const bool lat = row0 < M_LAT;
  {
      u16* U = (u16*)lds;
      float* Y = (float*)(lds + 80 * 256 * 2);
      int s0, n;
      if (lat) { s0 = (row0 >> 11) << 11; n = 2048; } else { s0 = M_LAT + (((row0 - M_LAT) >> 8) << 8); n = 256; }
      const int t0 = row0 - s0;
      for (int idx = tid; idx < 80 * 32; idx += 512) {
        int rr = idx >> 5, c8 = idx & 31;
        int t = t0 - 8 + rr;
        u32x4 v = (u32x4){0u, 0u, 0u, 0u};
        if (t >= 0 && t < n) v = *(const u32x4*)(p + (size_t)(s0 + t) * DIN + 768 + c8 * 8);
        *(u32x4*)(U + rr * 256 + c8 * 8) = v;
      }
      __syncthreads();
      {
        const int ch = tid & 255, tg = tid >> 8, g = ch >> 6, w = 2 << g;
        for (int tk = 0; tk < 32; ++tk) {
          int tok = tg * 32 + tk, t = t0 + tok;
          int lo = max(t - (w >> 1), 0), hi = min(t - (w >> 1) + w, n);
          float s = 0.f;
          for (int q = lo; q < hi; ++q) s += bf2f(U[(q - t0 + 8) * 256 + ch]);
          float mean = s / (float)(hi - lo);
          Y[tok * 256 + ch] = mean - bf2f(U[(tok + 8) * 256 + ch]);
        }
      }
      __syncthreads();
      {
        const int dcol = tid & 255, tg = tid >> 8, g = dcol >> 6, d = dcol & 63;
        const float* pw = P.pool_w + ((size_t)(l * 4 + g) * 64) * 64 + d;
        float acc[32];
#pragma unroll
        for (int tk = 0; tk < 32; ++tk) acc[tk] = 0.f;
        for (int c4 = 0; c4 < 16; ++c4) {
          float w0 = pw[(c4 * 4 + 0) * 64], w1 = pw[(c4 * 4 + 1) * 64], w2 = pw[(c4 * 4 + 2) * 64], w3 = pw[(c4 * 4 + 3) * 64];
#pragma unroll
          for (int tk = 0; tk < 32; ++tk) {
            float4 yv = *(const float4*)(Y + (tg * 32 + tk) * 256 + g * 64 + c4 * 4);
            acc[tk] += yv.x * w0 + yv.y * w1 + yv.z * w2 + yv.w * w3;
          }
        }
        const float psc = P.pool_scale[l * 256 + dcol];
#pragma unroll
        for (int tk = 0; tk < 32; ++tk)
          mix[(size_t)(row0 + tg * 32 + tk) * DM + 256 + dcol] = f2bf(acc[tk] * psc);
      }
      __syncthreads();
  }
}

DI void pp_phase(const Params& P, unsigned char* lds, int l, int wv) {
  u16* p = (u16*)(P.ws + WS_P);
  const float* tab = (const float*)(P.ws + WS_ROPE);
  for (int blk = get_bid(); blk < 256; blk += gridDim.x) {
    const int tid = get_tid(wv);
    const int row0 = blk * 72;
    if (tid < 144) {
      const int token = tid >> 1, kh = tid & 1, row = row0 + token;
      const bool lat = row < M_LAT;
      int bb, kidx;
      if (lat) { bb = row >> 11; kidx = row & 2047; } else { int rc = row - M_LAT; bb = rc >> 8; kidx = 2048 + (rc & 255); }
      unsigned char* img = P.ws + WS_KC + ((size_t)((bb * 2 + kh) * 36 + (kidx >> 6))) * 8192 + (kidx & 63) * 128;
      pp_normrope_one(p + (size_t)row * DIN + 1536 + kh * 64, P.k_norm_g + l * 64, lat, row & 2047, tab, img, ((kidx & 63) >> 1) & 7);
    }
    u16* T = (u16*)lds;
#pragma unroll
    for (int hv = 0; hv < 6; ++hv) {
      const int col = hv < 4 ? 512 + hv * 64 : 1664 + (hv - 4) * 64;
      for (int idx = tid; idx < 576; idx += 512) {
        const int token = idx >> 3, dc = idx & 7;
        const u32x4 v = *(const u32x4*)(p + (size_t)(row0 + token) * DIN + col + dc * 8);
#pragma unroll
        for (int j = 0; j < 4; ++j) {
          T[(hv * 64 + dc * 8 + 2 * j) * 80 + token] = (u16)(v[j] & 0xffffu);
          T[(hv * 64 + dc * 8 + 2 * j + 1) * 80 + token] = (u16)(v[j] >> 16);
        }
      }
    }
#pragma unroll
    for (int hk = 0; hk < 4; ++hk) {
      for (int idx = tid; idx < 576; idx += 512) {
        const int token = idx >> 3, dc = idx & 7, row = row0 + token;
        int b, keypos;
        if (row < M_LAT) { b = row >> 11; keypos = row & 2047; } else { int rc = row - M_LAT; b = rc >> 8; keypos = 2048 + (rc & 255); }
        const u32x4 v = *(const u32x4*)(p + (size_t)row * DIN + 256 + hk * 64 + dc * 8);
        const int key = keypos & 63;
        *(u32x4*)(P.ws + WS_KA + ((size_t)((b * 4 + hk) * 36 + (keypos >> 6))) * IMG_TILE + key * 128 + ((dc ^ ((key >> 1) & 7)) << 4)) = v;
      }
    }
    __syncthreads();
#pragma unroll
    for (int hv = 0; hv < 6; ++hv) {
      for (int idx = tid; idx < 576; idx += 512) {
        const int d = idx / 9, gi = idx - d * 9, row = row0 + gi * 8;
        int b, keypos;
        if (row < M_LAT) { b = row >> 11; keypos = row & 2047; } else { int rc = row - M_LAT; b = rc >> 8; keypos = 2048 + (rc & 255); }
        const u32x4 o = *(const u32x4*)(T + (hv * 64 + d) * 80 + gi * 8);
        unsigned char* dst = hv < 4 ? P.ws + WS_VA + ((size_t)((b * 4 + hv) * 36 + (keypos >> 6))) * IMG_TILE
                                    : P.ws + WS_VC + ((size_t)((b * 2 + hv - 4) * 36 + (keypos >> 6))) * IMG_TILE;
        *(u32x4*)(dst + d * 128 + ((((keypos & 63) >> 3) ^ ((d >> 1) & 7)) << 4)) = o;
      }
    }
    __syncthreads();
  }
}


template <int I0, int I1>
DI void na_softmax(f32x16& sc, f32x16& o0, f32x16& o1, float& mrun, float& lsum, const float* __restrict__ brow_, const int kcb,
                   const int w0, const int qcol, const float cs, const int lane) {
#pragma unroll
  for (int i = I0; i < I1; ++i) {
    const int kc = kcb + 8 * (i >> 2) + (i & 3);
    const bool valid = (kc >= w0) && (kc < w0 + 16);
    const int dx = min(max(kc - qcol, -15), 15) + 15;
    const float bv = brow_[dx];
    sc[i] = valid ? sc[i] * cs + bv : -1e30f;
  }
  float tmax = sc[I0];
#pragma unroll
  for (int i = I0 + 1; i < I1; ++i) tmax = fmaxf(tmax, sc[i]);
  tmax = fmaxf(tmax, shx(tmax, 32, lane));
  if (__builtin_amdgcn_ballot_w64(tmax > mrun + 4.f) != 0ull) {
    const float mnew = fmaxf(mrun, tmax);
    const float alpha = __builtin_amdgcn_exp2f(mrun - mnew);
    mrun = mnew;
    lsum *= alpha;
#pragma unroll
    for (int i = 0; i < 16; ++i) { o0[i] *= alpha; o1[i] *= alpha; }
  }
  float ps = 0.f;
#pragma unroll
  for (int i = 0; i < 16; ++i) {
    if (i >= I0 && i < I1) { sc[i] = __builtin_amdgcn_exp2f(sc[i] - mrun); ps += sc[i]; }
    else sc[i] = 0.f;
  }
  lsum += ps;
}


template <bool ROPE>
DI void q_normrope(bf16x8 (&bq)[4], const float* __restrict__ g, const float* __restrict__ tab, const int pos, const int hl, const int lane) {
  float x[4][8];
  float ss = 0.f;
#pragma unroll
  for (int ks = 0; ks < 4; ++ks) {
    const u32x4 raw = __builtin_bit_cast(u32x4, bq[ks]);
#pragma unroll
    for (int j = 0; j < 4; ++j) { x[ks][2 * j] = bf_lo(raw[j]); x[ks][2 * j + 1] = bf_hi(raw[j]); }
#pragma unroll
    for (int e = 0; e < 8; ++e) ss += x[ks][e] * x[ks][e];
  }
  ss += shx(ss, 32, lane);
  const float rs = rsqrtf(ss * (1.f / 64.f) + 1e-6f);
#pragma unroll
  for (int ks = 0; ks < 4; ++ks) {
    const float4 g0 = *(const float4*)(g + ks * 16 + hl * 8), g1 = *(const float4*)(g + ks * 16 + hl * 8 + 4);
    x[ks][0] *= rs * g0.x; x[ks][1] *= rs * g0.y; x[ks][2] *= rs * g0.z; x[ks][3] *= rs * g0.w;
    x[ks][4] *= rs * g1.x; x[ks][5] *= rs * g1.y; x[ks][6] *= rs * g1.z; x[ks][7] *= rs * g1.w;
  }
  if (ROPE) {
    const float2* tr = (const float2*)tab + (pos >> 6) * 16 + hl * 8;
    const float2* tc = (const float2*)tab + (pos & 63) * 16 + hl * 8;
#pragma unroll
    for (int e = 0; e < 8; ++e) {
      const float2 a = tr[e];
      const float x1 = x[0][e], x2 = x[1][e];
      x[0][e] = x1 * a.x - x2 * a.y; x[1][e] = x1 * a.y + x2 * a.x;
      const float2 c = tc[e];
      const float y1 = x[2][e], y2 = x[3][e];
      x[2][e] = y1 * c.x - y2 * c.y; x[3][e] = y1 * c.y + y2 * c.x;
    }
  }
#pragma unroll
  for (int ks = 0; ks < 4; ++ks) {
    u32x4 o;
#pragma unroll
    for (int j = 0; j < 4; ++j) o[j] = pk2(x[ks][2 * j], x[ks][2 * j + 1]);
    bq[ks] = __builtin_bit_cast(bf16x8, o);
  }
}


DI void store_ot_tile(u16* __restrict__ rowp, const u32x2 (&pk)[4], const int hl) {
#pragma unroll
  for (int j = 0; j < 4; j += 2) {
    const auto s0 = __builtin_amdgcn_permlane32_swap(pk[j][0], pk[j + 1][0], false, false);
    const auto s1 = __builtin_amdgcn_permlane32_swap(pk[j][1], pk[j + 1][1], false, false);
    u32x4 v; v[0] = s0[0]; v[1] = s1[0]; v[2] = s0[1]; v[3] = s1[1];
    *(u32x4*)(rowp + 8 * j + hl * 8) = v;
  }
}
template <bool NA, bool FIXED>
DI void attn_block(unsigned char* lds, const int tid, const u16* __restrict__ q, const unsigned char* __restrict__ kimg,
                   const unsigned char* __restrict__ vimg, const int tile0, const int nlat, u16* __restrict__ out,
                   const int act_lo, const int r, const int qcol0, const float* __restrict__ rpb_h, const float mfix, const float* __restrict__ qg) {
  const int lane = tid & 63, ql = lane & 31, hl = lane >> 5;
  const int nseq = nlat + 4;
  bf16x8 bq[4];
#pragma unroll
  for (int ks = 0; ks < 4; ++ks) bq[ks] = *(const bf16x8*)(q + (size_t)ql * DIN + ks * 16 + hl * 8);
  if (FIXED) q_normrope<false>(bq, qg, nullptr, 0, hl, lane);
  float* btab = (float*)(lds + 65536);
  if (NA) { if (tid < 465) btab[tid] = rpb_h[tid] * 1.4426950408889634f; }
  const unsigned char* kt = kimg + tid * 16;
  const unsigned char* vt = vimg + tid * 16;
  unsigned char* ldst = lds + tid * 16;
#define AT_TILE(i_) ((i_) < nlat ? tile0 + (i_) : 32 + (i_) - nlat)
#define AT_LOAD(i_) do { const int tl_ = AT_TILE(i_); \
    __builtin_amdgcn_global_load_lds((const unsigned*)(kt + (size_t)tl_ * IMG_TILE), (unsigned*)(ldst + ((i_) & 3) * 16384), 16, 0, 0); \
    __builtin_amdgcn_global_load_lds((const unsigned*)(vt + (size_t)tl_ * IMG_TILE), (unsigned*)(ldst + ((i_) & 3) * 16384 + 8192), 16, 0, 0); } while (0)
  AT_LOAD(0); AT_LOAD(1); AT_LOAD(2);
  f32x16 o0, o1;
#pragma unroll
  for (int i = 0; i < 16; ++i) { o0[i] = 0.f; o1[i] = 0.f; }
  float mrun = -1e30f, lsum = 0.f;
  const float cs = 0.125f * 1.4426950408889634f;
  const int swk = (ql >> 1) & 7;
  const int koff = ql * 128;
  const int voff = ql * 128 + hl * 8;
  const int qcol = qcol0 + ql;
  const int w0 = min(max(qcol - 8, 0), 48);
  for (int t = 0; t < nseq; ++t) {
    if (t + 2 < nseq) asm volatile("s_waitcnt vmcnt(4)" ::: "memory");
    else if (t + 1 < nseq) asm volatile("s_waitcnt vmcnt(2)" ::: "memory");
    else asm volatile("s_waitcnt vmcnt(0)" ::: "memory");
    __builtin_amdgcn_s_barrier();
    if (t + 3 < nseq) AT_LOAD(t + 3);
    const int tile = AT_TILE(t);
    const bool latent = t < nlat;
    if (NA && latent && (tile < act_lo || tile >= act_lo + 8)) continue;
    const unsigned char* sk = lds + (t & 3) * 16384;
    const unsigned char* sv = sk + 8192;
#pragma unroll
    for (int s2 = 0; s2 < 2; ++s2) {
      f32x16 sc;
#pragma unroll
      for (int i = 0; i < 16; ++i) sc[i] = 0.f;
#pragma unroll
      for (int ks = 0; ks < 4; ++ks) {
        bf16x8 ak = *(const bf16x8*)(sk + s2 * 4096 + koff + (((ks * 2 + hl) ^ swk) << 4));
        sc = __builtin_amdgcn_mfma_f32_32x32x16_bf16(ak, bq[ks], sc, 0, 0, 0);
      }
      const bool na_far = NA && latent && (s2 != (qcol0 >> 5));
      if (na_far) {
        const float* brow_ = btab + (tile - r + 7) * 31;
        const int kcb = s2 * 32 + hl * 4;
        if (qcol0 == 0) na_softmax<0, 4>(sc, o0, o1, mrun, lsum, brow_, kcb, w0, qcol, cs, lane);
        else na_softmax<12, 16>(sc, o0, o1, mrun, lsum, brow_, kcb, w0, qcol, cs, lane);
      } else {
      if (!FIXED) {
      float tmax;
      if (NA && latent) {
        const float* brow_ = btab + (tile - r + 7) * 31;
        const int kcb = s2 * 32 + hl * 4;
#pragma unroll
        for (int i = 0; i < 16; ++i) {
          int kc = kcb + 8 * (i >> 2) + (i & 3);
          bool valid = (kc >= w0) && (kc < w0 + 16);
          int dx = min(max(kc - qcol, -15), 15) + 15;
          float bv = brow_[dx];
          sc[i] = valid ? sc[i] * cs + bv : -1e30f;
        }
        tmax = fmaxf(fmaxf(sc[0], sc[1]), fmaxf(sc[2], sc[3]));
#pragma unroll
        for (int i = 4; i < 16; i += 4) tmax = fmaxf(tmax, fmaxf(fmaxf(sc[i], sc[i + 1]), fmaxf(sc[i + 2], sc[i + 3])));
      } else {
        tmax = fmaxf(fmaxf(sc[0], sc[1]), fmaxf(sc[2], sc[3]));
#pragma unroll
        for (int i = 4; i < 16; i += 4) tmax = fmaxf(tmax, fmaxf(fmaxf(sc[i], sc[i + 1]), fmaxf(sc[i + 2], sc[i + 3])));
        tmax *= cs;
      }
      tmax = fmaxf(tmax, shx(tmax, 32, lane));
      if (__builtin_amdgcn_ballot_w64(tmax > mrun + 4.f) != 0ull) {
        const float mnew = fmaxf(mrun, tmax);
        const float alpha = __builtin_amdgcn_exp2f(mrun - mnew);
        mrun = mnew;
        lsum *= alpha;
#pragma unroll
        for (int i = 0; i < 16; ++i) { o0[i] *= alpha; o1[i] *= alpha; }
      }
      }
      {
        const float mref = FIXED ? mfix : mrun;
        const f2_t m2 = {-mref, -mref};
        const f2_t c2 = (NA && latent) ? (f2_t){1.f, 1.f} : (f2_t){cs, cs};
        f2_t ps2 = {0.f, 0.f};
#pragma unroll
        for (int i = 0; i < 16; i += 2) {
          f2_t x = {sc[i], sc[i + 1]};
          x = x * c2 + m2;
          f2_t e = {__builtin_amdgcn_exp2f(x[0]), __builtin_amdgcn_exp2f(x[1])};
          sc[i] = e[0]; sc[i + 1] = e[1];
          ps2 += e;
        }
        lsum += ps2[0] + ps2[1];
      }
      }
#pragma unroll
      for (int kb = 0; kb < 2; ++kb) {
        u32x4 pp;
#pragma unroll
        for (int j = 0; j < 4; ++j) pp[j] = pk2(sc[kb * 8 + 2 * j], sc[kb * 8 + 2 * j + 1]);
        const bf16x8 pb = __builtin_bit_cast(bf16x8, pp);
        u32x4 a0, a1;
        {
          u32x2 x0 = *(const u32x2*)(sv + voff + (((s2 * 4 + kb * 2 + 0) ^ swk) << 4));
          u32x2 x1 = *(const u32x2*)(sv + voff + (((s2 * 4 + kb * 2 + 1) ^ swk) << 4));
          u32x2 y0 = *(const u32x2*)(sv + 4096 + voff + (((s2 * 4 + kb * 2 + 0) ^ swk) << 4));
          u32x2 y1 = *(const u32x2*)(sv + 4096 + voff + (((s2 * 4 + kb * 2 + 1) ^ swk) << 4));
          a0[0] = x0[0]; a0[1] = x0[1]; a0[2] = x1[0]; a0[3] = x1[1];
          a1[0] = y0[0]; a1[1] = y0[1]; a1[2] = y1[0]; a1[3] = y1[1];
        }
        o0 = __builtin_amdgcn_mfma_f32_32x32x16_bf16(__builtin_bit_cast(bf16x8, a0), pb, o0, 0, 0, 0);
        o1 = __builtin_amdgcn_mfma_f32_32x32x16_bf16(__builtin_bit_cast(bf16x8, a1), pb, o1, 0, 0, 0);
      }
    }
  }
#undef AT_LOAD
#undef AT_TILE
  const float ltot = lsum + shx(lsum, 32, lane);
  const float inv = 1.f / ltot;
  {
    u32x2 w0_[4], w1_[4];
#pragma unroll
    for (int j = 0; j < 4; ++j) {
      w0_[j][0] = pk2(o0[4 * j] * inv, o0[4 * j + 1] * inv); w0_[j][1] = pk2(o0[4 * j + 2] * inv, o0[4 * j + 3] * inv);
      w1_[j][0] = pk2(o1[4 * j] * inv, o1[4 * j + 1] * inv); w1_[j][1] = pk2(o1[4 * j + 2] * inv, o1[4 * j + 3] * inv);
    }
    store_ot_tile(out + (size_t)ql * DM, w0_, hl);
    store_ot_tile(out + (size_t)ql * DM + 32, w1_, hl);
  }
  asm volatile("s_waitcnt vmcnt(0)" ::: "memory");
  __builtin_amdgcn_s_barrier();
}


DI void gqa_block2(unsigned char* lds, const int tid, const u16* __restrict__ q, const unsigned char* __restrict__ kimg,
                   const unsigned char* __restrict__ vimg, u16* __restrict__ out, const float mfix,
                   const float* __restrict__ qg, const float* __restrict__ tab, const int pos0) {
  const int lane = tid & 63, ql = lane & 31, hl = lane >> 5;
  bf16x8 bq[2][4];
#pragma unroll
  for (int qt = 0; qt < 2; ++qt)
#pragma unroll
    for (int ks = 0; ks < 4; ++ks) bq[qt][ks] = *(const bf16x8*)(q + (size_t)(qt * 32 + ql) * DIN + ks * 16 + hl * 8);
  q_normrope<true>(bq[0], qg, tab, pos0 + ql, hl, lane);
  q_normrope<true>(bq[1], qg, tab, pos0 + 32 + ql, hl, lane);
  const unsigned char* kt = kimg + tid * 16;
  const unsigned char* vt = vimg + tid * 16;
  unsigned char* ldst = lds + tid * 16;
#define G2_LOAD(i_) do { \
    __builtin_amdgcn_global_load_lds((const unsigned*)(kt + (size_t)(i_) * IMG_TILE), (unsigned*)(ldst + ((i_) & 3) * 16384), 16, 0, 0); \
    __builtin_amdgcn_global_load_lds((const unsigned*)(vt + (size_t)(i_) * IMG_TILE), (unsigned*)(ldst + ((i_) & 3) * 16384 + 8192), 16, 0, 0); } while (0)
  G2_LOAD(0); G2_LOAD(1); G2_LOAD(2);
  f32x16 o[2][2];
#pragma unroll
  for (int qt = 0; qt < 2; ++qt)
#pragma unroll
    for (int i = 0; i < 16; ++i) { o[qt][0][i] = 0.f; o[qt][1][i] = 0.f; }
  f2_t ls[2] = {{0.f, 0.f}, {0.f, 0.f}};
  const float cs = 0.125f * 1.4426950408889634f;
  const f2_t c2 = {cs, cs}, m2 = {-mfix, -mfix};
  const int swk = (ql >> 1) & 7;
  const int koff = ql * 128;
  const int voff = ql * 128 + hl * 8;
  for (int t = 0; t < 36; ++t) {
    if (t + 2 < 36) asm volatile("s_waitcnt vmcnt(4)" ::: "memory");
    else if (t + 1 < 36) asm volatile("s_waitcnt vmcnt(2)" ::: "memory");
    else asm volatile("s_waitcnt vmcnt(0)" ::: "memory");
    __builtin_amdgcn_s_barrier();
    if (t + 3 < 36) G2_LOAD(t + 3);
    const unsigned char* sk = lds + (t & 3) * 16384;
    const unsigned char* sv = sk + 8192;
#pragma unroll
    for (int s2 = 0; s2 < 2; ++s2) {
      f32x16 sc[2];
#pragma unroll
      for (int i = 0; i < 16; ++i) { sc[0][i] = 0.f; sc[1][i] = 0.f; }
      bf16x8 ak[4];
#pragma unroll
      for (int ks = 0; ks < 4; ++ks) ak[ks] = *(const bf16x8*)(sk + s2 * 4096 + koff + (((ks * 2 + hl) ^ swk) << 4));
#pragma unroll
      for (int ks = 0; ks < 4; ++ks) sc[0] = __builtin_amdgcn_mfma_f32_32x32x16_bf16(ak[ks], bq[0][ks], sc[0], 0, 0, 0);
#pragma unroll
      for (int ks = 0; ks < 4; ++ks) sc[1] = __builtin_amdgcn_mfma_f32_32x32x16_bf16(ak[ks], bq[1][ks], sc[1], 0, 0, 0);
      u32x4 a0[2], a1[2];
#pragma unroll
      for (int kb = 0; kb < 2; ++kb) {
        const u32x2 x0 = *(const u32x2*)(sv + voff + (((s2 * 4 + kb * 2 + 0) ^ swk) << 4));
        const u32x2 x1 = *(const u32x2*)(sv + voff + (((s2 * 4 + kb * 2 + 1) ^ swk) << 4));
        const u32x2 y0 = *(const u32x2*)(sv + 4096 + voff + (((s2 * 4 + kb * 2 + 0) ^ swk) << 4));
        const u32x2 y1 = *(const u32x2*)(sv + 4096 + voff + (((s2 * 4 + kb * 2 + 1) ^ swk) << 4));
        a0[kb][0] = x0[0]; a0[kb][1] = x0[1]; a0[kb][2] = x1[0]; a0[kb][3] = x1[1];
        a1[kb][0] = y0[0]; a1[kb][1] = y0[1]; a1[kb][2] = y1[0]; a1[kb][3] = y1[1];
      }
#pragma unroll
      for (int qt = 0; qt < 2; ++qt) {
#pragma unroll
        for (int i = 0; i < 16; i += 2) {
          f2_t x = {sc[qt][i], sc[qt][i + 1]};
          x = x * c2 + m2;
          const f2_t e = {__builtin_amdgcn_exp2f(x[0]), __builtin_amdgcn_exp2f(x[1])};
          sc[qt][i] = e[0]; sc[qt][i + 1] = e[1];
          ls[qt] += e;
        }
#pragma unroll
        for (int kb = 0; kb < 2; ++kb) {
          u32x4 pp;
#pragma unroll
          for (int j = 0; j < 4; ++j) pp[j] = pk2(sc[qt][kb * 8 + 2 * j], sc[qt][kb * 8 + 2 * j + 1]);
          const bf16x8 pb = __builtin_bit_cast(bf16x8, pp);
          o[qt][0] = __builtin_amdgcn_mfma_f32_32x32x16_bf16(__builtin_bit_cast(bf16x8, a0[kb]), pb, o[qt][0], 0, 0, 0);
          o[qt][1] = __builtin_amdgcn_mfma_f32_32x32x16_bf16(__builtin_bit_cast(bf16x8, a1[kb]), pb, o[qt][1], 0, 0, 0);
        }
      }
    }
  }
#undef G2_LOAD
#pragma unroll
  for (int qt = 0; qt < 2; ++qt) {
    const float lsum = ls[qt][0] + ls[qt][1];
    const float inv = 1.f / (lsum + shx(lsum, 32, lane));
    u16* ob = out + (size_t)(qt * 32 + ql) * DM;
    u32x2 w0_[4], w1_[4];
#pragma unroll
    for (int j = 0; j < 4; ++j) {
      w0_[j][0] = pk2(o[qt][0][4 * j] * inv, o[qt][0][4 * j + 1] * inv); w0_[j][1] = pk2(o[qt][0][4 * j + 2] * inv, o[qt][0][4 * j + 3] * inv);
      w1_[j][0] = pk2(o[qt][1][4 * j] * inv, o[qt][1][4 * j + 1] * inv); w1_[j][1] = pk2(o[qt][1][4 * j + 2] * inv, o[qt][1][4 * j + 3] * inv);
    }
    store_ot_tile(ob, w0_, hl);
    store_ot_tile(ob + 32, w1_, hl);
  }
  asm volatile("s_waitcnt vmcnt(0)" ::: "memory");
  __builtin_amdgcn_s_barrier();
}

DI void att_phase(const Params& P, unsigned char* lds, int l, bool last, int wv) {
  const int wave = wv;
  const u16* p = (const u16*)(P.ws + WS_P);
  u16* mix = (u16*)(P.ws + WS_MIX);
  const int bid = get_bid(), G = gridDim.x;
  float mfix;
  {
    const int lane_ = get_tid(wv) & 63;
    float gq = fabsf(P.q_norm_g[l * 64 + lane_]), gk = fabsf(P.k_norm_g[l * 64 + lane_]);
#pragma unroll
    for (int o = 32; o >= 1; o >>= 1) { gq = fmaxf(gq, shx(gq, o, lane_)); gk = fmaxf(gk, shx(gk, o, lane_)); }
    mfix = 8.f * gq * gk * 1.4426950408889634f * 1.03f;
  }
  for (int rep_ = 0; rep_ < ((PROBE_DUP & 32) ? 2 : 1); ++rep_)
  for (int item = bid; item < 256; item += G) {
    const int b = item >> 5, kvh = (item >> 4) & 1, qblk = item & 15;
    const int h = kvh * 4 + (wave >> 1);
    const size_t qrow = (size_t)b * 2048 + qblk * 128 + (wave & 1) * 64;
    gqa_block2(lds, get_tid(wv), p + qrow * DIN + 1024 + h * 64,
               P.ws + WS_KC + (size_t)(b * 2 + kvh) * 36 * IMG_TILE, P.ws + WS_VC + (size_t)(b * 2 + kvh) * 36 * IMG_TILE,
               mix + qrow * DM + 512 + h * 64, mfix, P.q_norm_g + l * 64, (const float*)(P.ws + WS_ROPE), qblk * 128 + (wave & 1) * 64);
  }
  for (int rep_ = 0; rep_ < ((PROBE_DUP & 64) ? 2 : 1); ++rep_)
  for (int item = bid; item < 256; item += G) {
    const int b = item >> 5, h = (item >> 3) & 3, rg = item & 7;
    const int r = rg * 4 + (wave >> 1);
    const int r0 = min(max(r - 4, 0), 24);
    const int u_lo = min(max(rg * 4 - 4, 0), 24), u_hi = min(max(rg * 4 + 3 - 4, 0), 24) + 8;
    const size_t qrow = (size_t)b * 2048 + r * 64 + (wave & 1) * 32;
    attn_block<true, false>(lds, get_tid(wv), p + qrow * DIN + h * 64,
                     P.ws + WS_KA + (size_t)(b * 4 + h) * 36 * IMG_TILE, P.ws + WS_VA + (size_t)(b * 4 + h) * 36 * IMG_TILE,
                     u_lo, u_hi - u_lo, mix + qrow * DM + h * 64, r0, r, (wave & 1) * 32,
                     P.na_rpb + (size_t)(l * 4 + h) * 15 * 31, 0.f, nullptr);
  }
  if (!last) {
    for (int item = bid; item < 96; item += G) {
      if (item < 32) {
        const int b = item >> 2, h = item & 3;
        const size_t qrow = (size_t)M_LAT + b * 256 + wave * 32;
        attn_block<false, false>(lds, get_tid(wv), p + qrow * DIN + h * 64,
                          P.ws + WS_KA + (size_t)(b * 4 + h) * 36 * IMG_TILE, P.ws + WS_VA + (size_t)(b * 4 + h) * 36 * IMG_TILE,
                          0, 0, mix + qrow * DM + h * 64, 0, 0, 0, nullptr, 0.f, nullptr);
      } else {
        const int it2 = item - 32, b = it2 >> 3, h = it2 & 7, kvh = h >> 2;
        const size_t qrow = (size_t)M_LAT + b * 256 + wave * 32;
        attn_block<false, true>(lds, get_tid(wv), p + qrow * DIN + 1024 + h * 64,
                          P.ws + WS_KC + (size_t)(b * 2 + kvh) * 36 * IMG_TILE, P.ws + WS_VC + (size_t)(b * 2 + kvh) * 36 * IMG_TILE,
                          0, 0, mix + qrow * DM + 512 + h * 64, 0, 0, 0, nullptr, mfix, P.q_norm_g + l * 64);
      }
    }
  }
  {
    const int npool = last ? 256 : 288;
    for (int it = (bid + G - (96 % G)) % G; it < npool; it += G) pool_item(P, lds, l, it, get_tid(wv));
  }
}

#define XB_TMO      128
#define XB_XCNT(j)  (256  + 64 * (j))
#define XB_XSUB(j)  (1280 + 64 * (j))
#define XB_XGEN(j)  (2304 + 64 * (j))
#define XB_TOP      3328
#define XB_TOPGEN   3392
#define XB_SPIN_CAP (1u << 22)
#define LAS __attribute__((address_space(3)))
DI unsigned xb_ld(unsigned* p) { return __hip_atomic_load(p, __ATOMIC_RELAXED, __HIP_MEMORY_SCOPE_AGENT); }
DI unsigned xb_add(unsigned* p, unsigned v) { return __hip_atomic_fetch_add(p, v, __ATOMIC_RELAXED, __HIP_MEMORY_SCOPE_AGENT); }
DI unsigned xb_xcc_id() { return (unsigned)__builtin_amdgcn_s_getreg((3 << 11) | 20) & 0xFu; }
#define XB_SPIN(cond, bar) do { unsigned _sp = 0; while (cond) { __builtin_amdgcn_s_sleep(1); \
    if ((++_sp & 255u) == 0u) { if (xb_ld(&(bar)[XB_TMO])) break; if (_sp > XB_SPIN_CAP) { atomicAdd(&(bar)[XB_TMO], 1u); break; } } } } while (0)

DI void xcd_barrier_complete(unsigned* bar, unsigned x, unsigned& nloc, unsigned& nx) {
  const unsigned G = gridDim.x;
  unsigned sum, cnt, mine, sp = 0u;
  for (;;) {
    sum = 0u; cnt = 0u; mine = 0u;
#pragma unroll
    for (unsigned j = 0; j < 16; ++j) { const unsigned c = xb_ld(&bar[XB_XCNT(j)]); sum += c; cnt += (c > 0u) ? 1u : 0u; mine = (j == x) ? c : mine; }
    if (sum == G) break;
    __builtin_amdgcn_s_sleep(1);
    if ((++sp & 255u) == 0u) { if (xb_ld(&bar[XB_TMO])) break; if (sp > XB_SPIN_CAP) { atomicAdd(&bar[XB_TMO], 1u); break; } }
  }
  nloc = mine > 0u ? mine : 1u; nx = cnt > 0u ? cnt : 1u;
}

DI void xcd_barrier(unsigned* bar, const unsigned x, volatile LAS unsigned* st, const int tid) {
  asm volatile("s_waitcnt vmcnt(0)" ::: "memory");
  __syncthreads();
  if (tid == 0) {
    __builtin_amdgcn_s_waitcnt(0);
    unsigned nloc = st[0], nx = st[1];
    if (nloc == 0u) { xcd_barrier_complete(bar, x, nloc, nx); st[0] = nloc; st[1] = nx; }
    const unsigned old = xb_add(&bar[XB_XSUB(x)], 1u);
    const unsigned gen = old / nloc;
    if (old + 1u == (gen + 1u) * nloc) {
      __builtin_amdgcn_fence(__ATOMIC_RELEASE, "agent");
      asm volatile("s_waitcnt vmcnt(0)" ::: "memory");
      const unsigned og = xb_add(&bar[XB_TOP], 1u);
      const unsigned tg = og / nx;
      if (og + 1u == (tg + 1u) * nx) xb_add(&bar[XB_TOPGEN], 1u);
      else XB_SPIN(xb_ld(&bar[XB_TOPGEN]) == tg, bar);
      __builtin_amdgcn_fence(__ATOMIC_ACQUIRE, "agent");
      xb_add(&bar[XB_XGEN(x)], 1u);
      asm volatile("s_waitcnt vmcnt(0)" ::: "memory");
    } else {
      XB_SPIN(xb_ld(&bar[XB_XGEN(x)]) == gen, bar);
      __builtin_amdgcn_fence(__ATOMIC_ACQUIRE, "agent");
      asm volatile("s_waitcnt vmcnt(0)" ::: "memory");
    }
  }
  __syncthreads();
}

DI void drain_bg(const Params& P, unsigned char* lds, const int wv, const int lnext, const int which) {
  unsigned* ctr = (unsigned*)(P.ws + WS_BAR) + 3500 + lnext * 2 + which;
  volatile LAS int* slot = (volatile LAS int*)(lds + LDS_MAIN + 16);
  const int n_items = which == 0 ? 852 : 467;
  for (;;) {
    const int tid = get_tid(wv);
    __syncthreads();
    if (tid == 0) *slot = (int)xb_add(ctr, 1u);
    __syncthreads();
    const int it = *slot;
    if (it >= n_items) break;
    if (which == 0) {
      if (it < 36) p0_mod_item(P, lds, lnext * 36 + it, tid);
      else {
        const int i2 = it - 36;
        const int r = i2 < 352 ? i2 : (i2 < 464 ? 1056 + (i2 - 352) : 528 + (i2 - 464));
        p0_transpose_item(P, lds, lnext, r, tid);
      }
    } else {
      if (it < 416) {
        const int r = it < 176 ? 352 + it : (it < 352 ? 880 + (it - 176) : 1168 + (it - 352));
        p0_transpose_item(P, lds, lnext, r, tid);
      } else sw_item(P, lds, lnext, it - 416, tid);
    }
  }
}

__global__ void __launch_bounds__(512) mega(Params P0) {
  extern __shared__ __attribute__((aligned(16))) unsigned char lds[];
  cg::grid_group grid = cg::this_grid();
  const int wv = __builtin_amdgcn_readfirstlane((int)(threadIdx.x >> 6));
  volatile LAS unsigned* xb_st = (volatile LAS unsigned*)(lds + LDS_MAIN);
  unsigned* xb_bar = (unsigned*)(P0.ws + WS_BAR);
  const unsigned xb_x = xb_xcc_id();
  if (threadIdx.x == 0) { xb_st[0] = 0u; xb_st[1] = 0u; (void)xb_add(&xb_bar[XB_XCNT(xb_x)], 1u); }
  __syncthreads();
  for (int ph = P0.ph_lo; ph < P0.ph_hi; ++ph) {
    Params P = P0;
    {
      __attribute__((address_space(1))) unsigned char* w_ = (__attribute__((address_space(1))) unsigned char*)P0.ws;
      asm volatile("" : "+s"(w_));
      P.ws = (unsigned char*)w_; }
#if PROBE_DUP
    int nrep = 1;
    { const int s_ = (ph == 0) ? 100 : (ph == 1 ? 102 : (ph == NPH - 1 ? 101 : 200));
      if ((PROBE_DUP & 1) && s_ == 4) nrep = 2;
      if ((PROBE_DUP & 2) && (s_ == 0 || s_ == 6)) nrep = 2;
      if ((PROBE_DUP & 4) && s_ == 100) nrep = 2;
      if ((PROBE_DUP & 8) && s_ == 102) nrep = 2;
      if ((PROBE_DUP & 16) && s_ == 2) nrep = 2;
      if ((PROBE_DUP & 256) && (s_ == 1 || s_ == 7)) nrep = 2;
      if ((PROBE_DUP & 512) && s_ == 5) nrep = 2; }
    for (int rep = 0; rep < nrep; ++rep) {
      if (rep) xcd_barrier(xb_bar, xb_x, xb_st, get_tid(wv));
#endif
    if (ph == 0) {
      phase0(P, lds, wv);
    } else if (ph == 1) {
      phase0b(P, lds, wv);
    } else if (ph == NPH - 1) {
      final_phase(P, wv);
    } else {
      const int l = (ph - 2) / 7, s_ = (ph - 2) - l * 7;
      const int s = s_ < 3 ? s_ : s_ + 1;
      const bool last = (l == DEPTH - 1);
      const u16* wt = (const u16*)(P.ws + WS_WT) + (size_t)l * WT_LAYER;
      const float* mod = (const float*)(P.ws + WS_MOD) + (size_t)l * 9 * NMOD;
      float* h = (float*)(P.ws + WS_H);
      const u16* a = (const u16*)(P.ws + WS_A);
      const float* ssp = (const float*)(P.ws + WS_SSP);
      const float* swl = (const float*)(P.ws + WS_SW) + (size_t)l * 3 * 9 * SW_LD;
      if (s == 0 || s == 6) {
        EpiSwiglu E{(u16*)(P.ws + WS_ACT), ssp, s == 0 ? swl : swl + 2 * 9 * SW_LD, (const float*)(lds + LDS_RL), true};
        const u16* B = s == 0 ? wt : wt + WT_UP + WT_DN;
        gemm_phase<1024>(lds, wv, a, B, (last && s == 6) ? M_LAT : M_ALL, 5632, E);
        if (!last) drain_bg(P, lds, wv, l + 1, s == 0 ? 0 : 1);
      } else if (s == 1 || s == 5 || s == 7) {
        EpiResid E;
        const bool fromx = (l == 0 && s == 1);
        E.hin_lat = fromx ? P.x : h;
        E.hin_ctx = fromx ? P.ctx : h + (size_t)M_LAT * DM;
        E.hout = h;
#if PROBE_DUP
        if (rep + 1 < nrep) E.hout = (float*)(P.ws + WS_PROBE);
#endif
        const int gi = s == 1 ? 2 : (s == 5 ? 5 : 8);
        E.gate = mod + gi * 1024;
        E.coef = s == 5 ? 1.f : 0.5f;
        E.do_next = !(last && s == 7);
        E.hg = (u16*)(P.ws + WS_A);
        E.ssp = (float*)(P.ws + WS_SSP);
        E.ssl = (float*)(lds + LDS_SSL);
        if (s == 1) { E.gnext = P.norm_g + (l * 3 + 1) * 1024; E.scnext = mod + 4 * 1024; }
        else if (s == 5) { E.gnext = P.norm_g + (l * 3 + 2) * 1024; E.scnext = mod + 7 * 1024; }
        else { const int ln = last ? l : l + 1; E.gnext = P.norm_g + (ln * 3) * 1024; E.scnext = (const float*)(P.ws + WS_MOD) + (size_t)ln * 9 * NMOD + 1024; }
        const bool do_ctx = !(last && s != 1);
        const u16* Bw = s == 5 ? wt + 2 * WT_UP + 2 * WT_DN + WT_IN : (s == 1 ? wt + WT_UP : wt + 2 * WT_UP + WT_DN);
        const u16* Aop = s == 5 ? (const u16*)(P.ws + WS_MIX) : (const u16*)(P.ws + WS_ACT);
        if (s == 5) gemm_phase<1024>(lds, wv, Aop, Bw, M_LAT, 1024, E);
        else gemm_phase<DFF>(lds, wv, Aop, Bw, M_LAT, 1024, E);
        if (do_ctx) {
          SmallEpi SE;
          SE.hin = fromx ? P.ctx - (size_t)M_LAT * DM : h; SE.hout = E.hout; SE.gate = E.gate + 8 * NMOD; SE.coef = E.coef;
          SE.do_next = E.do_next; SE.hg = E.hg; SE.gnext = E.gnext; SE.scnext = E.scnext + 8 * NMOD;
          SE.sspc = (float*)(P.ws + WS_SSPC); SE.ssl = E.ssl;
          for (int bidx = get_bid(); bidx < 256; bidx += gridDim.x) {
            const int idx = bidx >> 3;
            const int pm = (bidx & 7) * 4 + (idx >> 3), pn = idx & 7;
            if (s == 5) gemm_small_tile<1024>(lds, get_tid(wv), Aop, Bw, M_LAT + pm * 64, pn * 128, SE);
            else gemm_small_tile<DFF>(lds, get_tid(wv), Aop, Bw, M_LAT + pm * 64, pn * 128, SE);
          }
        }
      } else if (s == 2) {
        EpiProj E{(u16*)(P.ws + WS_P), DIN, ssp, swl + 9 * SW_LD, (const float*)(lds + LDS_RL), true, P.ws,
                  P.k_norm_g + l * 64, (const float*)(P.ws + WS_ROPE), (float*)(lds + LDS_SSL)};
        gemm_phase<1024>(lds, wv, a, wt + 2 * WT_UP + 2 * WT_DN, M_ALL, DIN, E);
      } else {
        att_phase(P, lds, l, last, wv);
      }
    }
#if PROBE_DUP
    }
#endif
    if (ph + 1 < P0.ph_hi) {
      if (P0.ph_hi < 0) grid.sync();
      xcd_barrier(xb_bar, xb_x, xb_st, get_tid(wv));
#if (PROBE_DUP & 1024)
      for (int e_ = 0; e_ < 2; ++e_) xcd_barrier(xb_bar, xb_x, xb_st, get_tid(wv));
#endif
    }
  }
}

extern "C" void kernel_launch(void* const* d_in, const int* in_sizes, int n_in, void* d_out, int out_size,
                              void* d_ws, size_t ws_size, hipStream_t stream) {
  static int grid_blocks = 0;
  if (!grid_blocks) {
    if (ws_size < WS_TOTAL + (PROBE_DUP ? (size_t)M_ALL * 1024 * 4 : 0)) { fprintf(stderr, "workspace too small: %zu < %zu\n", ws_size, (size_t)WS_END); grid_blocks = -1; return; }
    int dev = 0, cus = 0, per_cu = 0;
    hipGetDevice(&dev);
    hipDeviceGetAttribute(&cus, hipDeviceAttributeMultiprocessorCount, dev);
    if (hipFuncSetAttribute((const void*)mega, hipFuncAttributeMaxDynamicSharedMemorySize, LDS_BYTES) != hipSuccess)
      fprintf(stderr, "hipFuncSetAttribute failed\n");
    hipOccupancyMaxActiveBlocksPerMultiprocessor(&per_cu, mega, 512, LDS_BYTES);
    if (per_cu < 1) per_cu = 1;
    grid_blocks = cus * per_cu;
    (void)hipGetLastError();
  }
  if (grid_blocks < 0) return;
  hipMemsetAsync((unsigned char*)d_ws + WS_BAR, 0, BAR_BYTES, stream);
  Params p{};
  const float** pp = (const float**)&p;
  for (int i = 0; i < 19; ++i) pp[i] = (const float*)d_in[i];
  p.out = (float*)d_out; p.ws = (unsigned char*)d_ws;
#if MULTI
  for (int ph = 0; ph < NPH; ++ph) {
    p.ph_lo = ph; p.ph_hi = ph + 1;
    hipLaunchKernelGGL(mega, dim3(grid_blocks), dim3(512), LDS_BYTES, stream, p);
  }
#else
  p.ph_lo = 0; p.ph_hi = NPH;
  void* args[] = {&p};
  hipError_t e = hipLaunchCooperativeKernel((void*)mega, dim3(grid_blocks), dim3(512), args, LDS_BYTES, stream);
  if (e != hipSuccess) fprintf(stderr, "cooperative launch failed: %s (grid %d)\n", hipGetErrorString(e), grid_blocks);
#endif
}
```

```cpp
#include <hip/hip_runtime.h>
#include <hip/hip_cooperative_groups.h>
#include <cstdio>
namespace cg = cooperative_groups;

#ifndef MULTI
#define MULTI 0
#endif
#ifndef PROBE_DUP
#define PROBE_DUP 0
#endif

typedef unsigned short u16;
typedef __bf16 bf2_t __attribute__((ext_vector_type(2)));
typedef float f2_t __attribute__((ext_vector_type(2)));
using bf16x8 = __attribute__((ext_vector_type(8))) short;
using f32x4 = __attribute__((ext_vector_type(4))) float;
using f32x16 = __attribute__((ext_vector_type(16))) float;
using u32x4 = __attribute__((ext_vector_type(4))) unsigned;
using u32x2 = __attribute__((ext_vector_type(2))) unsigned;

#define DI __device__ __forceinline__
#define LAUNDER_V(x) asm volatile("" : "+v"(x))
#define LAUNDER_S(x) asm volatile("" : "+s"(x))
DI int get_tid(int wv) {
  int t; const int wb = wv << 6;
  asm volatile("v_mbcnt_lo_u32_b32 %0, -1, 0\n\tv_mbcnt_hi_u32_b32 %0, -1, %0\n\tv_or_b32 %0, %1, %0" : "=&v"(t) : "s"(wb));
  return t;
}
DI float shx(float v, int mask, int lane) { return __int_as_float(__builtin_amdgcn_ds_bpermute((lane ^ mask) << 2, __float_as_int(v))); }

DI float sum_x32(float v) { const unsigned u = __float_as_uint(v); const auto r = __builtin_amdgcn_permlane32_swap(u, u, false, false); return __uint_as_float(r[0]) + __uint_as_float(r[1]); }
DI float max_x32(float v) { const unsigned u = __float_as_uint(v); const auto r = __builtin_amdgcn_permlane32_swap(u, u, false, false); return fmaxf(__uint_as_float(r[0]), __uint_as_float(r[1])); }
DI float sum_x16(float v) { const unsigned u = __float_as_uint(v); const auto r = __builtin_amdgcn_permlane16_swap(u, u, false, false); return __uint_as_float(r[0]) + __uint_as_float(r[1]); }
DI int get_bid() { int b = blockIdx.x; LAUNDER_S(b); return b; }

DI unsigned pk2(float a, float b) { f2_t v = {a, b}; bf2_t r = __builtin_convertvector(v, bf2_t); return __builtin_bit_cast(unsigned, r); }
DI u16 f2bf(float a) { return (u16)(pk2(a, 0.f) & 0xffffu); }
DI float bf_lo(unsigned u) { return __uint_as_float(u << 16); }
DI float bf_hi(unsigned u) { return __uint_as_float(u & 0xffff0000u); }
DI float bf2f(u16 v) { return __uint_as_float(((unsigned)v) << 16); }

constexpr int DM = 1024, DFF = 2816, DIN = 1792, DEPTH = 4;
constexpr int M_LAT = 16384, M_CTX = 2048, M_ALL = 18432;
constexpr int NMOD = 9216;
constexpr int VT_LD = 2304;

constexpr size_t al256(size_t x) { return (x + 255) & ~(size_t)255; }
constexpr size_t WS_ROPE = 0;
constexpr size_t WS_MOD = 8192;
constexpr size_t MOD_BYTES = (size_t)DEPTH * 9 * NMOD * 4;
constexpr size_t WS_WT = al256(WS_MOD + MOD_BYTES);
constexpr size_t WT_UP = (size_t)5632 * 1024, WT_DN = (size_t)1024 * 2816, WT_IN = (size_t)1792 * 1024, WT_OUT = (size_t)1024 * 1024;
constexpr size_t WT_LAYER = 2 * WT_UP + 2 * WT_DN + WT_IN + WT_OUT;
constexpr size_t WS_H = al256(WS_WT + WT_LAYER * DEPTH * 2);
constexpr size_t WS_A = WS_H + (size_t)M_ALL * 1024 * 4;
constexpr size_t WS_X = WS_A + (size_t)M_ALL * 1024 * 2;
constexpr size_t WS_ACT = WS_X;
constexpr size_t WS_P = WS_X;
constexpr size_t WS_MIX = WS_P + (size_t)M_ALL * DIN * 2;
constexpr size_t IMG_TILE = 8192;
constexpr size_t WS_KA = WS_MIX + (size_t)M_ALL * 1024 * 2;
constexpr size_t WS_VA = WS_KA + (size_t)8 * 4 * 36 * IMG_TILE;
constexpr size_t WS_KC = WS_VA + (size_t)8 * 4 * 36 * IMG_TILE;
constexpr size_t WS_VC = WS_KC + (size_t)8 * 2 * 36 * IMG_TILE;
constexpr size_t WS_END1 = WS_X + (size_t)M_ALL * DFF * 2;
constexpr size_t WS_END2 = WS_VC + (size_t)8 * 2 * 36 * IMG_TILE;
constexpr size_t WS_END = WS_END1 > WS_END2 ? WS_END1 : WS_END2;

constexpr size_t WS_SW = al256(WS_END);
constexpr size_t SW_LD = 5632;
constexpr size_t WS_SSP = WS_SW + (size_t)DEPTH * 3 * 9 * SW_LD * 4;
constexpr size_t WS_SSPC = WS_SSP + (size_t)M_ALL * 4 * 4;
constexpr size_t WS_BAR = al256(WS_SSPC + (size_t)M_CTX * 8 * 4);
constexpr size_t BAR_BYTES = 16384;
constexpr size_t WS_PROBE = WS_BAR + BAR_BYTES;
constexpr size_t WS_TOTAL = WS_BAR + BAR_BYTES;
constexpr int LDS_MAIN = 147456;
constexpr int LDS_SSL = LDS_MAIN + 64;
constexpr int LDS_RL = LDS_SSL + 4096;
constexpr int LDS_PF = LDS_RL + 1024;
constexpr int LDS_BYTES = LDS_PF + 256;
constexpr int NPH = 3 + DEPTH * 7;

struct Params {
  const float *x, *c, *ctx, *c_ctx, *w_ada, *b_ada, *norm_g, *ffn1_up, *ffn1_down, *ffn2_up, *ffn2_down,
      *w_in, *w_out, *na_rpb, *pool_w, *pool_scale, *q_norm_g, *k_norm_g, *final_g;
  float* out;
  unsigned char* ws;
  int ph_lo, ph_hi;
};

constexpr int HT = 128 * 64;

DI int lds_byte(int r, int c) {
  int st = (r >> 4) * 2 + (c >> 5), rr = r & 15, cc = c & 31, ob = rr * 64 + cc * 2;
  return st * 1024 + (ob ^ (((ob >> 9) & 1) << 5));
}
DI void stage_rc(int b, int& R, int& C) {
  int st = b / 1024, sb = b % 1024, swz = sb ^ (((sb >> 9) & 1) << 5);
  R = (st >> 1) * 16 + swz / 64; C = (st & 1) * 32 + (swz % 64) / 2;
}

template <int K, bool HALFM, class Epi>
DI void gemm_tile(unsigned char* lds, const int tid, const u16* __restrict__ A, const u16* __restrict__ Bt, int brow, int bcol, Epi& epi,
                  const bool prefetched, const bool has_next, const int nbrow, const int nbcol) {
  u16* shm = (u16*)lds;
#define SA(b, h) (shm + ((b) * 2 + (h)) * HT)
#define SB(b, h) (shm + (4 + (b) * 2 + (h)) * HT)
#define STAGE(P, BASE, br, kt) do { const char* _gb = (const char*)(BASE) + ((size_t)(br) * (size_t)K + (size_t)(kt) * 64) * 2; \
    const unsigned _m0 = ldsw + (unsigned)((const char*)(P) - (const char*)shm); \
    asm volatile("s_mov_b32 m0, %0\n\ts_nop 0\n\tglobal_load_lds_dwordx4 %2, %4\n\ts_mov_b32 m0, %1\n\ts_nop 0\n\tglobal_load_lds_dwordx4 %3, %4" \
                 :: "s"(_m0), "s"(_m0 + 8192u), "v"(voff0), "v"(voff1), "s"(_gb) : "m0", "memory"); } while (0)
#define LDA(dst, b, h) for (int m = 0; m < 4; ++m) for (int k = 0; k < 2; ++k) \
    dst[m][k] = *reinterpret_cast<const bf16x8*>((char*)SA(b, h) + lds_byte(wr * 64 + m * 16 + fr, k * 32 + fq * 8))
#define LDB(dst, b, h) for (int n = 0; n < 2; ++n) for (int k = 0; k < 2; ++k) \
    dst[n][k] = *reinterpret_cast<const bf16x8*>((char*)SB(b, h) + lds_byte(wc * 32 + n * 16 + fr, k * 32 + fq * 8))
#define MMA(ai, bj, At_, Bt_) do { __builtin_amdgcn_s_setprio(1); \
    for (int m = 0; m < 4; ++m) for (int n = 0; n < 2; ++n) for (int k = 0; k < 2; ++k) \
      acc[ai][bj][m][n] = __builtin_amdgcn_mfma_f32_16x16x32_bf16(Bt_[n][k], At_[m][k], acc[ai][bj][m][n], 0, 0, 0); \
    __builtin_amdgcn_s_setprio(0); } while (0)
#define MMA_H(ai, bj, At_, Bt_) do { if (!HALFM) MMA(ai, bj, At_, Bt_); } while (0)
#define WAIT_V(n) asm volatile("s_waitcnt vmcnt(" #n ")" ::: "memory")
#define WAIT_L(n) asm volatile("s_waitcnt lgkmcnt(" #n ")" ::: "memory")
#define BAR __builtin_amdgcn_s_barrier()
#define SCHED __builtin_amdgcn_sched_barrier(0)
  constexpr int HALF = 128;
  constexpr int AH = HALFM ? 0 : HALF;
  const int tid16 = tid * 16;
  const unsigned ldsw = (unsigned)__builtin_amdgcn_readfirstlane((int)(((unsigned)(size_t)lds) + (unsigned)(tid >> 6) * 1024u));
  unsigned voff0, voff1;
  { int r_, c_; stage_rc(tid16, r_, c_); voff0 = (unsigned)(r_ * K + c_) * 2u;
    stage_rc(tid16 + 8192, r_, c_); voff1 = (unsigned)(r_ * K + c_) * 2u; }
  const int wid = tid >> 6, lane = tid & 63, wr = wid >> 2, wc = wid & 3, fr = lane & 15, fq = lane >> 4;
  f32x4 acc[2][2][4][2];
#pragma unroll
  for (int a = 0; a < 2; ++a)
#pragma unroll
    for (int b = 0; b < 2; ++b)
#pragma unroll
      for (int m = 0; m < 4; ++m)
#pragma unroll
        for (int n = 0; n < 2; ++n) acc[a][b][m][n] = (f32x4){0.f, 0.f, 0.f, 0.f};
  bf16x8 At[4][2], B0[2][2], B1[2][2];
  const int nt = K / 64;
  {
    const char* pfb = (const char*)epi.prefetch_base(brow, bcol);
    if (pfb) {
      const unsigned pm0 = (unsigned)__builtin_amdgcn_readfirstlane((int)((unsigned)(size_t)lds + LDS_PF));
#pragma unroll
      for (int i = 0; i < 4; ++i) {
        const int li = tid + i * 512;
        const unsigned vo = (unsigned)((li >> 3) * DM * 4 + (li & 7) * 128);
        asm volatile("s_mov_b32 m0, %0\n\ts_nop 0\n\tglobal_load_lds_dword %1, %2" :: "s"(pm0), "v"(vo), "s"(pfb) : "m0", "memory");
      }
    }
  }
  const float4 pre_v = epi.pre_load(tid, brow);
  if (!prefetched) {
    STAGE(SB(0, 0), Bt, bcol, 0); STAGE(SA(0, 0), A, brow, 0);
    STAGE(SB(0, 1), Bt, bcol + HALF, 0); STAGE(SA(0, 1), A, brow + AH, 0);
  }
  if (wr == 1) BAR;
  if (!prefetched) WAIT_V(4);
  BAR;
  epi.pre_use(pre_v, tid, lds);
  if (!prefetched) {
    STAGE(SB(1, 0), Bt, bcol, 1); STAGE(SA(1, 0), A, brow, 1); STAGE(SB(1, 1), Bt, bcol + HALF, 1);
    WAIT_V(6);
  }
  BAR;
  for (int t = 0; t < nt - 2; t += 2) {
    LDB(B0, 0, 0); SCHED; LDA(At, 0, 0); STAGE(SA(1, 1), A, brow + AH, t + 1);
    WAIT_L(8); BAR; WAIT_L(0); MMA(0, 0, At, B0); BAR; SCHED;
    LDB(B1, 0, 1); STAGE(SB(0, 0), Bt, bcol, t + 2);
    BAR; WAIT_L(0); MMA(0, 1, At, B1); BAR;
    if (!HALFM) { LDA(At, 0, 1); } STAGE(SA(0, 0), A, brow, t + 2);
    BAR; WAIT_L(0); MMA_H(1, 0, At, B0); BAR; SCHED;
    STAGE(SB(0, 1), Bt, bcol + HALF, t + 2);
    WAIT_V(6); BAR; MMA_H(1, 1, At, B1); BAR;
    LDB(B0, 1, 0); SCHED; LDA(At, 1, 0); STAGE(SA(0, 1), A, brow + AH, t + 2);
    WAIT_L(8); BAR; WAIT_L(0); MMA(0, 0, At, B0); BAR; SCHED;
    LDB(B1, 1, 1); STAGE(SB(1, 0), Bt, bcol, t + 3);
    BAR; WAIT_L(0); MMA(0, 1, At, B1); BAR;
    if (!HALFM) { LDA(At, 1, 1); } STAGE(SA(1, 0), A, brow, t + 3);
    BAR; WAIT_L(0); MMA_H(1, 0, At, B0); BAR; SCHED;
    STAGE(SB(1, 1), Bt, bcol + HALF, t + 3);
    WAIT_V(6); BAR; MMA_H(1, 1, At, B1); BAR;
  }
  { LDB(B0, 0, 0); LDA(At, 0, 0); STAGE(SA(1, 1), A, brow + AH, nt - 1);
    BAR; WAIT_L(0); MMA(0, 0, At, B0); BAR;
    LDB(B1, 0, 1); BAR; WAIT_L(0); MMA(0, 1, At, B1); BAR;
    if (!HALFM) { LDA(At, 0, 1); } WAIT_V(4); BAR; WAIT_L(0); MMA_H(1, 0, At, B0); MMA_H(1, 1, At, B1); BAR; }
  { LDB(B0, 1, 0); LDA(At, 1, 0); WAIT_V(2); BAR; WAIT_L(0); MMA(0, 0, At, B0); BAR;
    LDB(B1, 1, 1); WAIT_V(0); BAR; WAIT_L(0); MMA(0, 1, At, B1); BAR;
    if (!HALFM) { LDA(At, 1, 1); } BAR; WAIT_L(0); MMA_H(1, 0, At, B0); MMA_H(1, 1, At, B1); BAR; }
  if (wr == 0) BAR;
  if (has_next) {
    STAGE(SB(0, 0), Bt, nbcol, 0); STAGE(SA(0, 0), A, nbrow, 0);
    STAGE(SB(0, 1), Bt, nbcol + HALF, 0); STAGE(SA(0, 1), A, nbrow + AH, 0);
    STAGE(SB(1, 0), Bt, nbcol, 1); STAGE(SA(1, 0), A, nbrow, 1); STAGE(SB(1, 1), Bt, nbcol + HALF, 1);
  }
  { int te = tid; LAUNDER_V(te); const int wid_ = te >> 6, lane_ = te & 63;
    epi(acc, brow, bcol, wid_ >> 2, wid_ & 3, lane_ & 15, lane_ >> 4, HALFM ? 1 : 2); }
  WAIT_V(0);
#undef SA
#undef SB
#undef STAGE
#undef LDA
#undef LDB
#undef MMA
#undef MMA_H
}

template <int K, class Epi>
DI void gemm_phase(unsigned char* lds, int wv, const u16* A, const u16* Bt, int M, int N, Epi& epi) {
  const int nM = M >> 8, nN = N >> 8, T = nM * nN;
  const int G = gridDim.x, b = get_bid(), nx = G >> 3;
  const int full = T / G, R = T - full * G;
  const bool half_tail = (R > 0) && (2 * R <= G) && epi.allow_half();
  const int Tmain = half_tail ? full * G : T;
  bool prefetched = false;
  for (int it = 0; it * G < Tmain; ++it) {
    const int L = ((G & 7) == 0) ? (it * 8 + (b & 7)) * nx + (b >> 3) : it * G + b;
    if (L < Tmain) {
      const int grp = L / (4 * nN), rem = L - grp * (4 * nN);
      const int gm = min(4, nM - grp * 4);
      const int pm = grp * 4 + rem % gm, pn = rem / gm;
      const int L2 = ((G & 7) == 0) ? ((it + 1) * 8 + (b & 7)) * nx + (b >> 3) : (it + 1) * G + b;
      const bool has_next = L2 < Tmain;
      int pm2 = 0, pn2 = 0;
      if (has_next) { const int grp2 = L2 / (4 * nN), rem2 = L2 - grp2 * (4 * nN); const int gm2 = min(4, nM - grp2 * 4); pm2 = grp2 * 4 + rem2 % gm2; pn2 = rem2 / gm2; }
      gemm_tile<K, false>(lds, get_tid(wv), A, Bt, pm * 256, pn * 256, epi, prefetched, has_next, pm2 * 256, pn2 * 256);
      prefetched = has_next;
    }
  }
  if (half_tail && b < 2 * R) {
    const int L = full * G + (b >> 1);
    const int grp = L / (4 * nN), rem = L - grp * (4 * nN);
    const int gm = min(4, nM - grp * 4);
    const int pm = grp * 4 + rem % gm, pn = rem / gm;
    gemm_tile<K, true>(lds, get_tid(wv), A, Bt, pm * 256 + (b & 1) * 128, pn * 256, epi, false, false, 0, 0);
  }
}

struct SmallEpi {
  const float* hin; float* hout; const float* gate; float coef;
  bool do_next; u16* hg; const float* gnext; const float* scnext; float* sspc; float* ssl;
};
template <int K>
DI void gemm_small_tile(unsigned char* lds, const int tid, const u16* __restrict__ A, const u16* __restrict__ Bt,
                        const int row0, const int col0, const SmallEpi& E) {
  const int wave = tid >> 6, lane = tid & 63, ql = lane & 31, hl = lane >> 5;
  const int wm = wave >> 2, wn = wave & 3;
  constexpr int NT = K / 64;
  const int grow = tid >> 3, gc = (tid & 7) ^ ((grow >> 1) & 7);
  const unsigned voff = (unsigned)(grow * K + gc * 8) * 2u;
  const char* ga = (const char*)(A + (size_t)row0 * K) + voff;
  const char* gb = (const char*)(Bt + (size_t)col0 * K) + voff;
  unsigned char* ldst = lds + tid * 16;
#define SM_LOAD(t_, st_) do { \
    __builtin_amdgcn_global_load_lds((const unsigned*)(ga + (size_t)(t_) * 128), (unsigned*)(ldst + (st_) * 24576), 16, 0, 0); \
    __builtin_amdgcn_global_load_lds((const unsigned*)(gb + (size_t)(t_) * 128), (unsigned*)(ldst + (st_) * 24576 + 8192), 16, 0, 0); \
    __builtin_amdgcn_global_load_lds((const unsigned*)(gb + (size_t)64 * K * 2 + (size_t)(t_) * 128), (unsigned*)(ldst + (st_) * 24576 + 16384), 16, 0, 0); } while (0)
  SM_LOAD(0, 0); SM_LOAD(1, 1); SM_LOAD(2, 2); SM_LOAD(3, 3); SM_LOAD(4, 4);
  f32x16 acc;
#pragma unroll
  for (int i = 0; i < 16; ++i) acc[i] = 0.f;
  const int swk = (ql >> 1) & 7;
  const int aoff = (wm * 32 + ql) * 128, boff = 8192 + (wn * 32 + ql) * 128;
  int stc = 0, stl = 5;
  for (int t = 0; t < NT; ++t) {
    if (t + 4 < NT) asm volatile("s_waitcnt vmcnt(12)" ::: "memory");
    else if (t + 3 < NT) asm volatile("s_waitcnt vmcnt(9)" ::: "memory");
    else if (t + 2 < NT) asm volatile("s_waitcnt vmcnt(6)" ::: "memory");
    else if (t + 1 < NT) asm volatile("s_waitcnt vmcnt(3)" ::: "memory");
    else asm volatile("s_waitcnt vmcnt(0)" ::: "memory");
    __builtin_amdgcn_s_barrier();
    if (t + 5 < NT) SM_LOAD(t + 5, stl);
    const unsigned char* st = lds + stc * 24576;
    stc = (stc == 5) ? 0 : stc + 1; stl = (stl == 5) ? 0 : stl + 1;
#pragma unroll
    for (int ks = 0; ks < 4; ++ks) {
      const bf16x8 af = *(const bf16x8*)(st + aoff + (((ks * 2 + hl) ^ swk) << 4));
      const bf16x8 bf = *(const bf16x8*)(st + boff + (((ks * 2 + hl) ^ swk) << 4));
      acc = __builtin_amdgcn_mfma_f32_32x32x16_bf16(af, bf, acc, 0, 0, 0);
    }
  }
#undef SM_LOAD
  const int col = col0 + wn * 32 + ql;
  const float gv = E.gate[col] * E.coef;
  const float gm = E.do_next ? E.gnext[col] * (1.f + E.scnext[col]) : 0.f;
  float hv[16];
#pragma unroll
  for (int i = 0; i < 16; ++i) {
    const int row = row0 + wm * 32 + 8 * (i >> 2) + 4 * hl + (i & 3);
    hv[i] = E.hin[(size_t)row * DM + col];
  }
#pragma unroll
  for (int i = 0; i < 16; ++i) {
    const int rloc = wm * 32 + 8 * (i >> 2) + 4 * hl + (i & 3);
    const size_t o = (size_t)(row0 + rloc) * DM + col;
    const float hn = hv[i] + gv * acc[i];
    E.hout[o] = hn;
    if (E.do_next) {
      E.hg[o] = f2bf(hn * gm);
      float sq = hn * hn;
      sq += shx(sq, 1, lane); sq += shx(sq, 2, lane); sq += shx(sq, 4, lane); sq += shx(sq, 8, lane); sq += shx(sq, 16, lane);
      if (ql == 0) E.ssl[wn * 64 + rloc] = sq;
    }
  }
  if (E.do_next) {
    __syncthreads();
    if (tid < 64) E.sspc[(size_t)(row0 - M_LAT + tid) * 8 + (col0 >> 7)] = (E.ssl[tid] + E.ssl[64 + tid]) + (E.ssl[128 + tid] + E.ssl[192 + tid]);
  }
  asm volatile("s_waitcnt vmcnt(0)" ::: "memory");
  __builtin_amdgcn_s_barrier();
}

DI float4 ld4(const float* p) { return *(const float4*)p; }
DI float silu_mul(float a, float b) { return a * b * __builtin_amdgcn_rcpf(1.f + __builtin_amdgcn_exp2f(a * -1.4426950408889634f)); }


DI void store_nn16(u16* __restrict__ blk0, const u32x2 a, const u32x2 b, const int fq) {
  const auto s0 = __builtin_amdgcn_permlane16_swap(a[0], b[0], false, false);
  const auto s1 = __builtin_amdgcn_permlane16_swap(a[1], b[1], false, false);
  u32x4 v; v[0] = s0[0]; v[1] = s1[0]; v[2] = s0[1]; v[3] = s1[1];
  *(u32x4*)(blk0 + (fq & 1) * 16 + (fq >> 1) * 8) = v;
}
struct EpiSwiglu {
  u16* act;
  const float* ssp;
  const float* sw;
  const float* rl;
  bool ctx8;
  DI bool allow_half() const { return true; }
  DI const float* prefetch_base(int, int) const { return nullptr; }
  DI float4 pre_load(int tid, int brow) const {
    if (brow < M_LAT || !ctx8) return *(const float4*)(ssp + (size_t)(brow + (tid & 255)) * 4);
    const float* q_ = ssp + (size_t)M_ALL * 4 + (size_t)(brow - M_LAT + (tid & 255)) * 8;
    const float4 a_ = *(const float4*)q_, b_ = *(const float4*)(q_ + 4);
    return make_float4(a_.x + b_.x, a_.y + b_.y, a_.z + b_.z, a_.w + b_.w);
  }
  DI void pre_use(const float4& pp, int tid, unsigned char* lds) const {
    if (tid < 256) ((float*)(lds + LDS_RL))[tid] = rsqrtf((pp.x + pp.y + pp.z + pp.w) * (1.f / 1024.f) + 1e-6f);
  }
  DI void operator()(f32x4 (&acc)[2][2][4][2], int brow, int bcol, int wr, int wc, int fr, int fq, const int nai) const {
    const int bi = brow < M_LAT ? (brow >> 11) : 8;
    const float* swr = sw + bi * SW_LD + bcol + wc * 32 + fq * 4;
    const float4 sa0 = ld4(swr), sa1 = ld4(swr + 16), sb0 = ld4(swr + 128), sb1 = ld4(swr + 144);
    u16* ob = act + (size_t)(brow + wr * 64 + fr) * DFF + (bcol >> 1) + wc * 32;
#pragma unroll
    for (int ai = 0; ai < 2; ++ai)
     if (ai < nai)
#pragma unroll
      for (int m = 0; m < 4; ++m) {
        const float r = rl[ai * 128 + wr * 64 + m * 16 + fr];
        u16* o_ = ob + (size_t)(ai * 128 + m * 16) * DFF;
        u32x2 p0, p1;
        {
          const f32x4 a = acc[ai][0][m][0], b = acc[ai][1][m][0];
          p0[0] = pk2(silu_mul(a[0] * r + sa0.x, b[0] * r + sb0.x), silu_mul(a[1] * r + sa0.y, b[1] * r + sb0.y));
          p0[1] = pk2(silu_mul(a[2] * r + sa0.z, b[2] * r + sb0.z), silu_mul(a[3] * r + sa0.w, b[3] * r + sb0.w));
        }
        {
          const f32x4 a = acc[ai][0][m][1], b = acc[ai][1][m][1];
          p1[0] = pk2(silu_mul(a[0] * r + sa1.x, b[0] * r + sb1.x), silu_mul(a[1] * r + sa1.y, b[1] * r + sb1.y));
          p1[1] = pk2(silu_mul(a[2] * r + sa1.z, b[2] * r + sb1.z), silu_mul(a[3] * r + sa1.w, b[3] * r + sb1.w));
        }
        store_nn16(o_, p0, p1, fq);
      }
  }
};

struct EpiBf16 {
  u16* out; int ld;
  const float* ssp;
  const float* sw;
  const float* rl;
  bool ctx8;
  DI bool allow_half() const { return true; }
  DI const float* prefetch_base(int, int) const { return nullptr; }
  DI float4 pre_load(int tid, int brow) const {
    if (brow < M_LAT || !ctx8) return *(const float4*)(ssp + (size_t)(brow + (tid & 255)) * 4);
    const float* q_ = ssp + (size_t)M_ALL * 4 + (size_t)(brow - M_LAT + (tid & 255)) * 8;
    const float4 a_ = *(const float4*)q_, b_ = *(const float4*)(q_ + 4);
    return make_float4(a_.x + b_.x, a_.y + b_.y, a_.z + b_.z, a_.w + b_.w);
  }
  DI void pre_use(const float4& pp, int tid, unsigned char* lds) const {
    if (tid < 256) ((float*)(lds + LDS_RL))[tid] = rsqrtf((pp.x + pp.y + pp.z + pp.w) * (1.f / 1024.f) + 1e-6f);
  }
  DI void operator()(f32x4 (&acc)[2][2][4][2], int brow, int bcol, int wr, int wc, int fr, int fq, const int nai) const {
    const int bi = brow < M_LAT ? (brow >> 11) : 8;
    const float* swr = sw + bi * SW_LD + bcol + wc * 32 + fq * 4;
    float4 sv[2][2];
    sv[0][0] = ld4(swr); sv[0][1] = ld4(swr + 16); sv[1][0] = ld4(swr + 128); sv[1][1] = ld4(swr + 144);
    u16* ob = out + (size_t)(brow + wr * 64 + fr) * ld + bcol + wc * 32 + fq * 4;
#pragma unroll
    for (int ai = 0; ai < 2; ++ai)
     if (ai < nai)
#pragma unroll
      for (int m = 0; m < 4; ++m) {
        const float r = rl[ai * 128 + wr * 64 + m * 16 + fr];
        u16* o_ = ob + (size_t)(ai * 128 + m * 16) * ld;
#pragma unroll
        for (int bj = 0; bj < 2; ++bj)
#pragma unroll
          for (int n = 0; n < 2; ++n) {
            const f32x4 a = acc[ai][bj][m][n];
            const float4 s4 = sv[bj][n];
            u32x2 pk; pk[0] = pk2(a[0] * r + s4.x, a[1] * r + s4.y); pk[1] = pk2(a[2] * r + s4.z, a[3] * r + s4.w);
            *(u32x2*)(o_ + bj * 128 + n * 16) = pk;
          }
      }
  }
};


DI void store_kimg16(unsigned char* __restrict__ rowp, const u32x2 a, const u32x2 b, const int fq, const int cbase, const int swz) {
  const auto s0 = __builtin_amdgcn_permlane16_swap(a[0], b[0], false, false);
  const auto s1 = __builtin_amdgcn_permlane16_swap(a[1], b[1], false, false);
  u32x4 v; v[0] = s0[0]; v[1] = s1[0]; v[2] = s0[1]; v[3] = s1[1];
  const int chunk = cbase + (fq & 1) * 2 + (fq >> 1);
  *(u32x4*)(rowp + ((chunk ^ swz) << 4)) = v;
}
struct EpiProj {
  u16* out; int ld;
  const float* ssp;
  const float* sw;
  const float* rl;
  bool ctx8;
  unsigned char* ws;
  const float* kg;
  const float* tab;
  float* ssl;
  DI bool allow_half() const { return false; }
  DI const float* prefetch_base(int, int) const { return nullptr; }
  DI float4 pre_load(int tid, int brow) const {
    if (brow < M_LAT || !ctx8) return *(const float4*)(ssp + (size_t)(brow + (tid & 255)) * 4);
    const float* q_ = ssp + (size_t)M_ALL * 4 + (size_t)(brow - M_LAT + (tid & 255)) * 8;
    const float4 a_ = *(const float4*)q_, b_ = *(const float4*)(q_ + 4);
    return make_float4(a_.x + b_.x, a_.y + b_.y, a_.z + b_.z, a_.w + b_.w);
  }
  DI void pre_use(const float4& pp, int tid, unsigned char* lds) const {
    if (tid < 256) ((float*)(lds + LDS_RL))[tid] = rsqrtf((pp.x + pp.y + pp.z + pp.w) * (1.f / 1024.f) + 1e-6f);
  }
  DI void keyof(int row, int& b, int& keypos) const {
    if (row < M_LAT) { b = row >> 11; keypos = row & 2047; } else { const int rc = row - M_LAT; b = rc >> 8; keypos = 2048 + (rc & 255); }
  }
  DI void operator()(f32x4 (&acc)[2][2][4][2], int brow, int bcol, int wr, int wc, int fr, int fq, const int nai) const {
    const int bi = brow < M_LAT ? (brow >> 11) : 8;
    const int pn = bcol >> 8;
    const int lane = fq * 16 + fr;
    const float* swr = sw + bi * SW_LD + bcol + wc * 32 + fq * 4;
    float4 sv[2][2];
    sv[0][0] = ld4(swr); sv[0][1] = ld4(swr + 16); sv[1][0] = ld4(swr + 128); sv[1][1] = ld4(swr + 144);
#pragma unroll
    for (int ai = 0; ai < 2; ++ai)
#pragma unroll
      for (int m = 0; m < 4; ++m) {
        const float r = rl[ai * 128 + wr * 64 + m * 16 + fr];
#pragma unroll
        for (int bj = 0; bj < 2; ++bj)
#pragma unroll
          for (int n = 0; n < 2; ++n) {
            f32x4 a = acc[ai][bj][m][n];
            const float4 s4 = sv[bj][n];
            a[0] = a[0] * r + s4.x; a[1] = a[1] * r + s4.y; a[2] = a[2] * r + s4.z; a[3] = a[3] * r + s4.w;
            acc[ai][bj][m][n] = a;
          }
      }
    if (pn == 0 || (pn >= 3 && pn <= 5)) {
      u16* ob = out + (size_t)(brow + wr * 64 + fr) * ld + bcol + wc * 32;
#pragma unroll
      for (int ai = 0; ai < 2; ++ai)
#pragma unroll
        for (int m = 0; m < 4; ++m)
#pragma unroll
          for (int bj = 0; bj < 2; ++bj) {
            const f32x4 a = acc[ai][bj][m][0], b = acc[ai][bj][m][1];
            u32x2 p0, p1; p0[0] = pk2(a[0], a[1]); p0[1] = pk2(a[2], a[3]); p1[0] = pk2(b[0], b[1]); p1[1] = pk2(b[2], b[3]);
            store_nn16(ob + (size_t)(ai * 128 + m * 16) * ld + bj * 128, p0, p1, fq);
          }
      return;
    }
    const int hsub = wc >> 1;
    const int dbase = (wc & 1) * 32 + fq * 4;
    if (pn == 6) {
#pragma unroll
      for (int ai = 0; ai < 2; ++ai)
#pragma unroll
        for (int m = 0; m < 4; ++m) {
          const f32x4 a0 = acc[ai][0][m][0], a1 = acc[ai][0][m][1];
          float sq = a0[0] * a0[0] + a0[1] * a0[1] + a0[2] * a0[2] + a0[3] * a0[3] + a1[0] * a1[0] + a1[1] * a1[1] + a1[2] * a1[2] + a1[3] * a1[3];
          sq = sum_x16(sq); sq = sum_x32(sq);
          if (fq == 0) ssl[wc * 256 + ai * 128 + wr * 64 + m * 16 + fr] = sq;
        }
      __syncthreads();
      const float4 g0 = ld4(kg + dbase), g1 = ld4(kg + dbase + 16);
#pragma unroll
      for (int ai = 0; ai < 2; ++ai)
#pragma unroll
        for (int m = 0; m < 4; ++m) {
          const int rloc = ai * 128 + wr * 64 + m * 16 + fr;
          const int row = brow + rloc;
          const float rs = rsqrtf((ssl[wc * 256 + rloc] + ssl[(wc ^ 1) * 256 + rloc]) * (1.f / 64.f) + 1e-6f);
          f32x4 y1 = acc[ai][0][m][0], y2 = acc[ai][0][m][1];
          y1[0] *= rs * g0.x; y1[1] *= rs * g0.y; y1[2] *= rs * g0.z; y1[3] *= rs * g0.w;
          y2[0] *= rs * g1.x; y2[1] *= rs * g1.y; y2[2] *= rs * g1.z; y2[3] *= rs * g1.w;
          if (row < M_LAT) {
            const int pos = row & 2047;
            const float* tp = tab + (((wc & 1) ? (pos & 63) : (pos >> 6)) * 16 + fq * 4) * 2;
            const float4 c01 = ld4(tp), c23 = ld4(tp + 4);
            float t_;
            t_ = y1[0] * c01.x - y2[0] * c01.y; y2[0] = y1[0] * c01.y + y2[0] * c01.x; y1[0] = t_;
            t_ = y1[1] * c01.z - y2[1] * c01.w; y2[1] = y1[1] * c01.w + y2[1] * c01.z; y1[1] = t_;
            t_ = y1[2] * c23.x - y2[2] * c23.y; y2[2] = y1[2] * c23.y + y2[2] * c23.x; y1[2] = t_;
            t_ = y1[3] * c23.z - y2[3] * c23.w; y2[3] = y1[3] * c23.w + y2[3] * c23.z; y1[3] = t_;
          }
          int b, keypos; keyof(row, b, keypos);
          const int key = keypos & 63, swz = (key >> 1) & 7;
          unsigned char* img = ws + WS_KC + ((size_t)((b * 2 + hsub) * 36 + (keypos >> 6))) * IMG_TILE + key * 128;
          u32x2 p1, p2; p1[0] = pk2(y1[0], y1[1]); p1[1] = pk2(y1[2], y1[3]); p2[0] = pk2(y2[0], y2[1]); p2[1] = pk2(y2[2], y2[3]);
          store_kimg16(img, p1, p2, fq, (wc & 1) * 4, swz);
        }
    }
    if (pn == 1) {
#pragma unroll
      for (int ai = 0; ai < 2; ++ai)
#pragma unroll
        for (int m = 0; m < 4; ++m) {
          const int row = brow + ai * 128 + wr * 64 + m * 16 + fr;
          int b, keypos; keyof(row, b, keypos);
          const int key = keypos & 63, swz = (key >> 1) & 7;
          const int c0 = (wc & 1) * 4 + (fq >> 1);
#pragma unroll
          for (int bj = 0; bj < 2; ++bj) {
            unsigned char* img = ws + WS_KA + ((size_t)((b * 4 + bj * 2 + hsub) * 36 + (keypos >> 6))) * IMG_TILE + key * 128;
            const f32x4 a = acc[ai][bj][m][0], bb_ = acc[ai][bj][m][1];
            u32x2 p0, p1; p0[0] = pk2(a[0], a[1]); p0[1] = pk2(a[2], a[3]); p1[0] = pk2(bb_[0], bb_[1]); p1[1] = pk2(bb_[2], bb_[3]);
            store_kimg16(img, p0, p1, fq, (wc & 1) * 4, swz);
          }
        }
    }
    if (pn == 2 || pn == 6) {
#pragma unroll
      for (int ai = 0; ai < 2; ++ai)
#pragma unroll
        for (int m = 0; m < 4; ++m) {
          const int row = brow + ai * 128 + wr * 64 + m * 16 + fr;
          int b, keypos; keyof(row, b, keypos);
          const int key = keypos & 63;
#pragma unroll
          for (int bj = 0; bj < 2; ++bj) {
            if (pn == 6 && bj == 0) continue;
            unsigned char* img = (pn == 2 ? ws + WS_VA + ((size_t)((b * 4 + bj * 2 + hsub) * 36 + (keypos >> 6))) * IMG_TILE
                                          : ws + WS_VC + ((size_t)((b * 2 + hsub) * 36 + (keypos >> 6))) * IMG_TILE) + (key & 7) * 2;
#pragma unroll
            for (int n = 0; n < 2; ++n) {
              const f32x4 a = acc[ai][bj][m][n];
#pragma unroll
              for (int j = 0; j < 4; ++j) {
                const int d = dbase + n * 16 + j;
                *(u16*)(img + d * 128 + ((((key >> 3)) ^ ((d >> 1) & 7)) << 4)) = f2bf(a[j]);
              }
            }
          }
        }
    }
  }
};

struct EpiResid {
  const float* hin_lat;
  const float* hin_ctx;
  float* hout;
  const float* gate;
  float coef;
  bool do_next;
  u16* hg;
  const float* gnext;
  const float* scnext;
  float* ssp;
  float* ssl;
  DI bool allow_half() const { return false; }
  DI const float* prefetch_base(int brow, int bcol) const { return (brow < M_LAT ? hin_lat : hin_ctx - (size_t)M_LAT * DM) + (size_t)brow * DM + bcol; }
  DI float4 pre_load(int tid, int) const { const float z = (float)tid; return make_float4(z, z, z, z); }
  DI void pre_use(const float4&, int, unsigned char*) const {}
  DI void operator()(f32x4 (&acc)[2][2][4][2], int brow, int bcol, int wr, int wc, int fr, int fq, const int nai) const {
    const int bi = brow < M_LAT ? (brow >> 11) : 8;
    const float* hin = brow < M_LAT ? hin_lat : hin_ctx - (size_t)M_LAT * DM;
    const float* g = gate + bi * NMOD;
    const int lane = fq * 16 + fr;
    const int c0 = bcol + wc * 32 + fq * 4;
    float4 gv[2][2], gm[2][2];
#pragma unroll
    for (int bj = 0; bj < 2; ++bj)
#pragma unroll
      for (int n = 0; n < 2; ++n) {
        const int col = c0 + bj * 128 + n * 16;
        float4 t_ = ld4(g + col);
        gv[bj][n] = make_float4(t_.x * coef, t_.y * coef, t_.z * coef, t_.w * coef);
        if (do_next) {
          const float4 gg = ld4(gnext + col), sc = ld4(scnext + bi * NMOD + col);
          gm[bj][n] = make_float4(gg.x * (1.f + sc.x), gg.y * (1.f + sc.y), gg.z * (1.f + sc.z), gg.w * (1.f + sc.w));
        } else gm[bj][n] = gv[bj][n];
      }
#pragma unroll
    for (int aim = 0; aim < 4; ++aim) {
      const int ai = aim >> 1, mh = (aim & 1) * 2;
      float4 t[2][2][2];
#pragma unroll
      for (int m2 = 0; m2 < 2; ++m2) {
        const float* hi_ = hin + (size_t)(brow + ai * 128 + wr * 64 + (mh + m2) * 16 + fr) * DM + c0;
#pragma unroll
        for (int bj = 0; bj < 2; ++bj)
#pragma unroll
          for (int n = 0; n < 2; ++n) t[m2][bj][n] = ld4(hi_ + bj * 128 + n * 16);
      }
#pragma unroll
      for (int m2 = 0; m2 < 2; ++m2) {
        const int m = mh + m2;
        const int rloc = ai * 128 + wr * 64 + m * 16 + fr;
        float* ho_ = hout + (size_t)(brow + rloc) * DM + c0;
        u16* hg_ = hg + (size_t)(brow + rloc) * DM + bcol + wc * 32;
        u32x2 hpk[2];
        float sq = 0.f;
#pragma unroll
        for (int bj = 0; bj < 2; ++bj)
#pragma unroll
          for (int n = 0; n < 2; ++n) {
            const f32x4 a = acc[ai][bj][m][n];
            const float4 gvv = gv[bj][n];
            float4 hn = t[m2][bj][n];
            hn.x += gvv.x * a[0]; hn.y += gvv.y * a[1]; hn.z += gvv.z * a[2]; hn.w += gvv.w * a[3];
            *(float4*)(ho_ + bj * 128 + n * 16) = hn;
            if (do_next) {
              sq += hn.x * hn.x + hn.y * hn.y + hn.z * hn.z + hn.w * hn.w;
              const float4 gmm = gm[bj][n];
              hpk[n][0] = pk2(hn.x * gmm.x, hn.y * gmm.y); hpk[n][1] = pk2(hn.z * gmm.z, hn.w * gmm.w);
              if (n == 1) store_nn16(hg_ + bj * 128, hpk[0], hpk[1], fq);
            }
          }
        if (do_next) {
          sq = sum_x16(sq); sq = sum_x32(sq);
          if (fq == 0) ssl[wc * 256 + rloc] = sq;
        }
      }
      __builtin_amdgcn_sched_barrier(0);
    }
    if (do_next) {
      __syncthreads();
      const int tid_ = (wr * 4 + wc) * 64 + lane;
      if (tid_ < 256) ssp[(size_t)(brow + tid_) * 4 + (bcol >> 8)] = (ssl[tid_] + ssl[256 + tid_]) + (ssl[512 + tid_] + ssl[768 + tid_]);
    }
  }
};

DI void p0_transpose_item(const Params& P, unsigned char* lds, int l, int r, const int tid) {
  u16* wt = (u16*)(P.ws + WS_WT) + (size_t)l * WT_LAYER;
  const float* src; u16* dst; int K, N, perm = 0;
  if (r < 352) { src = P.ffn1_up + (size_t)l * 1024 * 5632; K = 1024; N = 5632; dst = wt; perm = 1; }
  else if (r < 528) { r -= 352; src = P.ffn1_down + (size_t)l * 2816 * 1024; K = 2816; N = 1024; dst = wt + WT_UP; }
  else if (r < 880) { r -= 528; src = P.ffn2_up + (size_t)l * 1024 * 5632; K = 1024; N = 5632; dst = wt + WT_UP + WT_DN; perm = 1; }
  else if (r < 1056) { r -= 880; src = P.ffn2_down + (size_t)l * 2816 * 1024; K = 2816; N = 1024; dst = wt + 2 * WT_UP + WT_DN; }
  else if (r < 1168) { r -= 1056; src = P.w_in + (size_t)l * 1024 * DIN; K = 1024; N = DIN; dst = wt + 2 * WT_UP + 2 * WT_DN; }
  else { r -= 1168; src = P.w_out + (size_t)l * 1024 * 1024; K = 1024; N = 1024; dst = wt + 2 * WT_UP + 2 * WT_DN + WT_IN; }
  const int nN = N >> 8;
  const int kt = r / nN, ntl = r - kt * nN;
  const int k0 = kt * 64, n0 = ntl * 256;
  float* T = (float*)lds;
  float4 v[8];
#pragma unroll
  for (int i = 0; i < 8; ++i) {
    const int idx = tid + i * 512, k = idx >> 6, n4 = idx & 63;
    v[i] = *(const float4*)(src + (size_t)(k0 + k) * N + n0 + n4 * 4);
  }
#pragma unroll
  for (int i = 0; i < 8; ++i) {
    const int idx = tid + i * 512, k = idx >> 6, n4 = idx & 63;
    *(float4*)(T + k * 260 + ((n4 ^ (k >> 3)) << 2)) = v[i];
  }
  __syncthreads();
#pragma unroll
  for (int i = 0; i < 4; ++i) {
    const int idx = tid + i * 512, n = idx >> 3, c = idx & 7;
    float e[8];
#pragma unroll
    for (int j = 0; j < 8; ++j) e[j] = T[(c * 8 + j) * 260 + ((((n >> 2) ^ c)) << 2) + (n & 3)];
    u32x4 o; o[0] = pk2(e[0], e[1]); o[1] = pk2(e[2], e[3]); o[2] = pk2(e[4], e[5]); o[3] = pk2(e[6], e[7]);
    const int ng = n0 + n;
    int drow = ng;
    if (perm) drow = (ng < DFF) ? ((ng >> 7) * 256 + (ng & 127)) : ((((ng - DFF) >> 7) * 256) + 128 + ((ng - DFF) & 127));
    *(u32x4*)(dst + (size_t)drow * K + k0 + c * 8) = o;
  }
  __syncthreads();
}

DI void p0_mod_item(const Params& P, unsigned char* lds, int idx, const int tid) {
  const int wave = tid >> 6, lane = tid & 63;
  const int l = idx / 36, cch = idx - l * 36;
  float* sl = (float*)lds;
  float* red = sl + 9 * 1024;
  for (int i = tid; i < 9 * 1024; i += 512) {
    int r = i >> 10, k = i & 1023;
    float cv = r < 8 ? P.c[r * 1024 + k] : P.c_ctx[k];
    sl[i] = cv / (1.f + expf(-cv));
  }
  __syncthreads();
  float4 acc[9];
#pragma unroll
  for (int r = 0; r < 9; ++r) acc[r] = make_float4(0.f, 0.f, 0.f, 0.f);
  const float* W = P.w_ada + ((size_t)l * 1024 + wave * 128) * NMOD + cch * 256 + lane * 4;
  for (int k4 = 0; k4 < 32; ++k4) {
    float4 w0 = *(const float4*)(W + (size_t)(k4 * 4 + 0) * NMOD);
    float4 w1 = *(const float4*)(W + (size_t)(k4 * 4 + 1) * NMOD);
    float4 w2 = *(const float4*)(W + (size_t)(k4 * 4 + 2) * NMOD);
    float4 w3 = *(const float4*)(W + (size_t)(k4 * 4 + 3) * NMOD);
#pragma unroll
    for (int r = 0; r < 9; ++r) {
      float4 s4 = *(const float4*)(sl + r * 1024 + wave * 128 + k4 * 4);
      acc[r].x += s4.x * w0.x + s4.y * w1.x + s4.z * w2.x + s4.w * w3.x;
      acc[r].y += s4.x * w0.y + s4.y * w1.y + s4.z * w2.y + s4.w * w3.y;
      acc[r].z += s4.x * w0.z + s4.y * w1.z + s4.z * w2.z + s4.w * w3.z;
      acc[r].w += s4.x * w0.w + s4.y * w1.w + s4.z * w2.w + s4.w * w3.w;
    }
  }
#pragma unroll
  for (int r = 0; r < 9; ++r) *(float4*)(red + (wave * 9 + r) * 256 + lane * 4) = acc[r];
  __syncthreads();
  float* mod = (float*)(P.ws + WS_MOD);
  for (int o = tid; o < 2304; o += 512) {
    int r = o >> 8, cc = o & 255;
    float sacc = P.b_ada[l * NMOD + cch * 256 + cc];
#pragma unroll
    for (int w = 0; w < 8; ++w) sacc += red[(w * 9 + r) * 256 + cc];
    mod[((size_t)l * 9 + r) * NMOD + cch * 256 + cc] = sacc;
  }
  __syncthreads();
}

DI void phase0(const Params& P, unsigned char* lds, int wv) {
  const int NMODI = 36, NTR = 1232;
  const int total = NMODI + NTR + 1;
  const int tid = get_tid(wv);
  for (int it = get_bid(); it < total; it += gridDim.x) {
    if (it < NMODI) p0_mod_item(P, lds, it, tid);
    else if (it < NMODI + NTR) p0_transpose_item(P, lds, 0, it - NMODI, tid);
    else {
      float* tab = (float*)(P.ws + WS_ROPE);
      for (int e = tid; e < 1024; e += 512) {
        int pos = e >> 4, i = e & 15;
        float inv = powf(10000.f, -(float)(2 * i) / 32.f);
        float ang = (float)pos * inv;
        tab[e * 2] = cosf(ang); tab[e * 2 + 1] = sinf(ang);
      }
    }
  }
}

DI float wave_sum(float v, int lane) {
#pragma unroll
  for (int o = 32; o >= 1; o >>= 1) v += shx(v, o, lane);
  return v;
}

DI void sw_item(const Params& P, unsigned char* lds, const int l, const int r, const int tid) {
  const int wave = tid >> 6, lane = tid & 63;
  const float* mod = (const float*)(P.ws + WS_MOD);
  u16* shl = (u16*)lds;
  const int ql = lane & 31, hl = lane >> 5;
  {
    int st, ch;
    if (r < 22) { st = 0; ch = r; } else if (r < 29) { st = 1; ch = r - 22; } else { st = 2; ch = r - 29; }
    const u16* wt = (const u16*)(P.ws + WS_WT) + (size_t)l * WT_LAYER + (st == 0 ? 0 : (st == 1 ? 2 * WT_UP + 2 * WT_DN : WT_UP + WT_DN));
    for (int i = tid; i < 9 * 1024; i += 512) {
      const float v = mod[((size_t)l * 9 + (i >> 10)) * NMOD + (st * 3) * 1024 + (i & 1023)];
      const u16 hi = f2bf(v);
      shl[(i >> 10) * 1032 + (i & 1023)] = hi;
      shl[9 * 1032 + (i >> 10) * 1032 + (i & 1023)] = f2bf(v - bf2f(hi));
    }
    __syncthreads();
    const int n0 = ch * 256 + wave * 32;
    const u16* wrow = wt + (size_t)(n0 + ql) * 1024 + hl * 8;
    f32x16 acc;
#pragma unroll
    for (int i = 0; i < 16; ++i) acc[i] = 0.f;
#pragma unroll 8
    for (int kk = 0; kk < 64; ++kk) {
      const bf16x8 aw = *(const bf16x8*)(wrow + kk * 16);
      bf16x8 bh = (bf16x8){0, 0, 0, 0, 0, 0, 0, 0}, bl = (bf16x8){0, 0, 0, 0, 0, 0, 0, 0};
      if (ql < 9) {
        bh = *(const bf16x8*)(shl + ql * 1032 + kk * 16 + hl * 8);
        bl = *(const bf16x8*)(shl + 9 * 1032 + ql * 1032 + kk * 16 + hl * 8);
      }
      acc = __builtin_amdgcn_mfma_f32_32x32x16_bf16(aw, bh, acc, 0, 0, 0);
      acc = __builtin_amdgcn_mfma_f32_32x32x16_bf16(aw, bl, acc, 0, 0, 0);
    }
    if (ql < 9) {
      float* swo = (float*)(P.ws + WS_SW) + ((size_t)(l * 3 + st) * 9 + ql) * SW_LD + n0 + hl * 4;
#pragma unroll
      for (int j = 0; j < 4; ++j) *(float4*)(swo + 8 * j) = make_float4(acc[4 * j], acc[4 * j + 1], acc[4 * j + 2], acc[4 * j + 3]);
    }
    __syncthreads();
  }
}

DI void phase0b(const Params& P, unsigned char* lds, int wv) {
  const int tid = get_tid(wv);
  const int wave = tid >> 6, lane = tid & 63;
  const int bid = get_bid(), G = gridDim.x;
  const float* mod = (const float*)(P.ws + WS_MOD);
  for (int it = bid; it < 51; it += G) sw_item(P, lds, 0, it, tid);
  u16* hg = (u16*)(P.ws + WS_A);
  float* ssp = (float*)(P.ws + WS_SSP);
  for (int row = bid * 8 + wave; row < M_ALL; row += G * 8) {
    const float* src = row < M_LAT ? P.x + (size_t)row * DM : P.ctx + (size_t)(row - M_LAT) * DM;
    const int bi = row < M_LAT ? (row >> 11) : 8;
    const float* sc = mod + bi * NMOD + 1024;
    float ss = 0.f;
#pragma unroll
    for (int i = 0; i < 4; ++i) {
      const int c = i * 256 + lane * 4;
      const float4 v = *(const float4*)(src + c);
      ss += v.x * v.x + v.y * v.y + v.z * v.z + v.w * v.w;
      const float4 gg = *(const float4*)(P.norm_g + c), s4 = *(const float4*)(sc + c);
      u32x2 o; o[0] = pk2(v.x * gg.x * (1.f + s4.x), v.y * gg.y * (1.f + s4.y)); o[1] = pk2(v.z * gg.z * (1.f + s4.z), v.w * gg.w * (1.f + s4.w));
      *(u32x2*)(hg + (size_t)row * DM + c) = o;
    }
    ss = wave_sum(ss, lane);
    if (lane == 0) {
      const float z = ss * 0.f;
      if (row < M_LAT) *(float4*)(ssp + (size_t)row * 4) = make_float4(ss, z, z, z);
      else { float* q_ = ssp + (size_t)M_ALL * 4 + (size_t)(row - M_LAT) * 8; *(float4*)q_ = make_float4(ss, z, z, z); *(float4*)(q_ + 4) = make_float4(z, z, z, z); }
    }
  }
}

DI void final_phase(const Params& P, int wv) {
  const int tid = get_tid(wv);
  const int wave = tid >> 6, lane = tid & 63;
  const float* h = (const float*)(P.ws + WS_H);
  for (int row = get_bid() * 8 + wave; row < M_LAT; row += gridDim.x * 8) {
    const float* src = h + (size_t)row * DM;
    float4 v[4]; float ss = 0.f;
#pragma unroll
    for (int i = 0; i < 4; ++i) {
      v[i] = *(const float4*)(src + i * 256 + lane * 4);
      ss += v[i].x * v[i].x + v[i].y * v[i].y + v[i].z * v[i].z + v[i].w * v[i].w;
    }
    ss = wave_sum(ss, lane);
    const float r = rsqrtf(ss * (1.f / 1024.f) + 1e-6f);
#pragma unroll
    for (int i = 0; i < 4; ++i) {
      int c = i * 256 + lane * 4;
      float4 gg = *(const float4*)(P.final_g + c);
      float4 o = make_float4(v[i].x * r * gg.x, v[i].y * r * gg.y, v[i].z * r * gg.z, v[i].w * r * gg.w);
      *(float4*)(P.out + (size_t)row * DM + c) = o;
    }
  }
}

DI void pp_normrope_one(u16* ptr, const float* __restrict__ g, bool rope, int pos, const float* __restrict__ tab, unsigned char* img, int swz) {
  float x[64];
#pragma unroll
  for (int i = 0; i < 8; ++i) {
    u32x4 raw = *(const u32x4*)(ptr + i * 8);
#pragma unroll
    for (int j = 0; j < 4; ++j) { x[i * 8 + 2 * j] = bf_lo(raw[j]); x[i * 8 + 2 * j + 1] = bf_hi(raw[j]); }
  }
  float ss = 0.f;
#pragma unroll
  for (int d = 0; d < 64; ++d) ss += x[d] * x[d];
  const float r = rsqrtf(ss * (1.f / 64.f) + 1e-6f);
#pragma unroll
  for (int d = 0; d < 64; ++d) x[d] = x[d] * r * g[d];
  if (rope) {
    const float2* tr = (const float2*)tab + (pos >> 6) * 16;
    const float2* tc = (const float2*)tab + (pos & 63) * 16;
#pragma unroll
    for (int i = 0; i < 16; ++i) {
      float2 cs = tr[i];
      float x1 = x[i], x2 = x[16 + i];
      x[i] = x1 * cs.x - x2 * cs.y; x[16 + i] = x1 * cs.y + x2 * cs.x;
      float2 cs2 = tc[i];
      float y1 = x[32 + i], y2 = x[48 + i];
      x[32 + i] = y1 * cs2.x - y2 * cs2.y; x[48 + i] = y1 * cs2.y + y2 * cs2.x;
    }
  }
#pragma unroll
  for (int i = 0; i < 8; ++i) {
    u32x4 o;
#pragma unroll
    for (int j = 0; j < 4; ++j) o[j] = pk2(x[i * 8 + 2 * j], x[i * 8 + 2 * j + 1]);
    *(u32x4*)(ptr + i * 8) = o;
    if (img) *(u32x4*)(img + ((i ^ swz) << 4)) = o;
  }
}

DI void pool_item(const Params& P, unsigned char* lds, const int l, const int tt, const int tid) {
  const u16* p = (const u16*)(P.ws + WS_P);
  u16* mix = (u16*)(P.ws + WS_MIX);
  const int row0 = tt * 64;
  const bool lat = row0 < M_LAT;
  {
      u16* U = (u16*)lds;
      float* Y = (float*)(lds + 80 * 256 * 2);
      int s0, n;
      if (lat) { s0 = (row0 >> 11) << 11; n = 2048; } else { s0 = M_LAT + (((row0 - M_LAT) >> 8) << 8); n = 256; }
      const int t0 = row0 - s0;
      for (int idx = tid; idx < 80 * 32; idx += 512) {
        int rr = idx >> 5, c8 = idx & 31;
        int t = t0 - 8 + rr;
        u32x4 v = (u32x4){0u, 0u, 0u, 0u};
        if (t >= 0 && t < n) v = *(const u32x4*)(p + (size_t)(s0 + t) * DIN + 768 + c8 * 8);
        *(u32x4*)(U + rr * 256 + c8 * 8) = v;
      }
      __syncthreads();
      {
        const int ch = tid & 255, tg = tid >> 8, g = ch >> 6, w = 2 << g;
        for (int tk = 0; tk < 32; ++tk) {
          int tok = tg * 32 + tk, t = t0 + tok;
          int lo = max(t - (w >> 1), 0), hi = min(t - (w >> 1) + w, n);
          float s = 0.f;
          for (int q = lo; q < hi; ++q) s += bf2f(U[(q - t0 + 8) * 256 + ch]);
          float mean = s / (float)(hi - lo);
          Y[tok * 256 + ch] = mean - bf2f(U[(tok + 8) * 256 + ch]);
        }
      }
      __syncthreads();
      {
        const int dcol = tid & 255, tg = tid >> 8, g = dcol >> 6, d = dcol & 63;
        const float* pw = P.pool_w + ((size_t)(l * 4 + g) * 64) * 64 + d;
        float acc[32];
#pragma unroll
        for (int tk = 0; tk < 32; ++tk) acc[tk] = 0.f;
        for (int c4 = 0; c4 < 16; ++c4) {
          float w0 = pw[(c4 * 4 + 0) * 64], w1 = pw[(c4 * 4 + 1) * 64], w2 = pw[(c4 * 4 + 2) * 64], w3 = pw[(c4 * 4 + 3) * 64];
#pragma unroll
          for (int tk = 0; tk < 32; ++tk) {
            float4 yv = *(const float4*)(Y + (tg * 32 + tk) * 256 + g * 64 + c4 * 4);
            acc[tk] += yv.x * w0 + yv.y * w1 + yv.z * w2 + yv.w * w3;
          }
        }
        const float psc = P.pool_scale[l * 256 + dcol];
#pragma unroll
        for (int tk = 0; tk < 32; ++tk)
          mix[(size_t)(row0 + tg * 32 + tk) * DM + 256 + dcol] = f2bf(acc[tk] * psc);
      }
      __syncthreads();
  }
}

DI void pp_phase(const Params& P, unsigned char* lds, int l, int wv) {
  u16* p = (u16*)(P.ws + WS_P);
  const float* tab = (const float*)(P.ws + WS_ROPE);
  for (int blk = get_bid(); blk < 256; blk += gridDim.x) {
    const int tid = get_tid(wv);
    const int row0 = blk * 72;
    if (tid < 144) {
      const int token = tid >> 1, kh = tid & 1, row = row0 + token;
      const bool lat = row < M_LAT;
      int bb, kidx;
      if (lat) { bb = row >> 11; kidx = row & 2047; } else { int rc = row - M_LAT; bb = rc >> 8; kidx = 2048 + (rc & 255); }
      unsigned char* img = P.ws + WS_KC + ((size_t)((bb * 2 + kh) * 36 + (kidx >> 6))) * 8192 + (kidx & 63) * 128;
      pp_normrope_one(p + (size_t)row * DIN + 1536 + kh * 64, P.k_norm_g + l * 64, lat, row & 2047, tab, img, ((kidx & 63) >> 1) & 7);
    }
    u16* T = (u16*)lds;
#pragma unroll
    for (int hv = 0; hv < 6; ++hv) {
      const int col = hv < 4 ? 512 + hv * 64 : 1664 + (hv - 4) * 64;
      for (int idx = tid; idx < 576; idx += 512) {
        const int token = idx >> 3, dc = idx & 7;
        const u32x4 v = *(const u32x4*)(p + (size_t)(row0 + token) * DIN + col + dc * 8);
#pragma unroll
        for (int j = 0; j < 4; ++j) {
          T[(hv * 64 + dc * 8 + 2 * j) * 80 + token] = (u16)(v[j] & 0xffffu);
          T[(hv * 64 + dc * 8 + 2 * j + 1) * 80 + token] = (u16)(v[j] >> 16);
        }
      }
    }
#pragma unroll
    for (int hk = 0; hk < 4; ++hk) {
      for (int idx = tid; idx < 576; idx += 512) {
        const int token = idx >> 3, dc = idx & 7, row = row0 + token;
        int b, keypos;
        if (row < M_LAT) { b = row >> 11; keypos = row & 2047; } else { int rc = row - M_LAT; b = rc >> 8; keypos = 2048 + (rc & 255); }
        const u32x4 v = *(const u32x4*)(p + (size_t)row * DIN + 256 + hk * 64 + dc * 8);
        const int key = keypos & 63;
        *(u32x4*)(P.ws + WS_KA + ((size_t)((b * 4 + hk) * 36 + (keypos >> 6))) * IMG_TILE + key * 128 + ((dc ^ ((key >> 1) & 7)) << 4)) = v;
      }
    }
    __syncthreads();
#pragma unroll
    for (int hv = 0; hv < 6; ++hv) {
      for (int idx = tid; idx < 576; idx += 512) {
        const int d = idx / 9, gi = idx - d * 9, row = row0 + gi * 8;
        int b, keypos;
        if (row < M_LAT) { b = row >> 11; keypos = row & 2047; } else { int rc = row - M_LAT; b = rc >> 8; keypos = 2048 + (rc & 255); }
        const u32x4 o = *(const u32x4*)(T + (hv * 64 + d) * 80 + gi * 8);
        unsigned char* dst = hv < 4 ? P.ws + WS_VA + ((size_t)((b * 4 + hv) * 36 + (keypos >> 6))) * IMG_TILE
                                    : P.ws + WS_VC + ((size_t)((b * 2 + hv - 4) * 36 + (keypos >> 6))) * IMG_TILE;
        *(u32x4*)(dst + d * 128 + ((((keypos & 63) >> 3) ^ ((d >> 1) & 7)) << 4)) = o;
      }
    }
    __syncthreads();
  }
}


template <int I0, int I1>
DI void na_softmax(f32x16& sc, f32x16& o0, f32x16& o1, float& mrun, float& lsum, const float* __restrict__ brow_, const int kcb,
                   const int w0, const int qcol, const float cs, const int lane) {
#pragma unroll
  for (int i = I0; i < I1; ++i) {
    const int kc = kcb + 8 * (i >> 2) + (i & 3);
    const bool valid = (kc >= w0) && (kc < w0 + 16);
    const int dx = min(max(kc - qcol, -15), 15) + 15;
    const float bv = brow_[dx];
    sc[i] = valid ? sc[i] * cs + bv : -1e30f;
  }
  float tmax = sc[I0];
#pragma unroll
  for (int i = I0 + 1; i < I1; ++i) tmax = fmaxf(tmax, sc[i]);
  tmax = max_x32(tmax);
  if (__builtin_amdgcn_ballot_w64(tmax > mrun + 4.f) != 0ull) {
    const float mnew = fmaxf(mrun, tmax);
    const float alpha = __builtin_amdgcn_exp2f(mrun - mnew);
    mrun = mnew;
    lsum *= alpha;
#pragma unroll
    for (int i = 0; i < 16; ++i) { o0[i] *= alpha; o1[i] *= alpha; }
  }
  float ps = 0.f;
#pragma unroll
  for (int i = 0; i < 16; ++i) {
    if (i >= I0 && i < I1) { sc[i] = __builtin_amdgcn_exp2f(sc[i] - mrun); ps += sc[i]; }
    else sc[i] = 0.f;
  }
  lsum += ps;
}


template <bool ROPE>
DI void q_normrope(bf16x8 (&bq)[4], const float* __restrict__ g, const float* __restrict__ tab, const int pos, const int hl, const int lane) {
  float x[4][8];
  float ss = 0.f;
#pragma unroll
  for (int ks = 0; ks < 4; ++ks) {
    const u32x4 raw = __builtin_bit_cast(u32x4, bq[ks]);
#pragma unroll
    for (int j = 0; j < 4; ++j) { x[ks][2 * j] = bf_lo(raw[j]); x[ks][2 * j + 1] = bf_hi(raw[j]); }
#pragma unroll
    for (int e = 0; e < 8; ++e) ss += x[ks][e] * x[ks][e];
  }
  ss = sum_x32(ss);
  const float rs = rsqrtf(ss * (1.f / 64.f) + 1e-6f);
#pragma unroll
  for (int ks = 0; ks < 4; ++ks) {
    const float4 g0 = *(const float4*)(g + ks * 16 + hl * 8), g1 = *(const float4*)(g + ks * 16 + hl * 8 + 4);
    x[ks][0] *= rs * g0.x; x[ks][1] *= rs * g0.y; x[ks][2] *= rs * g0.z; x[ks][3] *= rs * g0.w;
    x[ks][4] *= rs * g1.x; x[ks][5] *= rs * g1.y; x[ks][6] *= rs * g1.z; x[ks][7] *= rs * g1.w;
  }
  if (ROPE) {
    const float2* tr = (const float2*)tab + (pos >> 6) * 16 + hl * 8;
    const float2* tc = (const float2*)tab + (pos & 63) * 16 + hl * 8;
#pragma unroll
    for (int e = 0; e < 8; ++e) {
      const float2 a = tr[e];
      const float x1 = x[0][e], x2 = x[1][e];
      x[0][e] = x1 * a.x - x2 * a.y; x[1][e] = x1 * a.y + x2 * a.x;
      const float2 c = tc[e];
      const float y1 = x[2][e], y2 = x[3][e];
      x[2][e] = y1 * c.x - y2 * c.y; x[3][e] = y1 * c.y + y2 * c.x;
    }
  }
#pragma unroll
  for (int ks = 0; ks < 4; ++ks) {
    u32x4 o;
#pragma unroll
    for (int j = 0; j < 4; ++j) o[j] = pk2(x[ks][2 * j], x[ks][2 * j + 1]);
    bq[ks] = __builtin_bit_cast(bf16x8, o);
  }
}


DI void store_ot_tile(u16* __restrict__ rowp, const u32x2 (&pk)[4], const int hl) {
#pragma unroll
  for (int j = 0; j < 4; j += 2) {
    const auto s0 = __builtin_amdgcn_permlane32_swap(pk[j][0], pk[j + 1][0], false, false);
    const auto s1 = __builtin_amdgcn_permlane32_swap(pk[j][1], pk[j + 1][1], false, false);
    u32x4 v; v[0] = s0[0]; v[1] = s1[0]; v[2] = s0[1]; v[3] = s1[1];
    *(u32x4*)(rowp + 8 * j + hl * 8) = v;
  }
}
template <bool NA, bool FIXED>
DI void attn_block(unsigned char* lds, const int tid, const u16* __restrict__ q, const unsigned char* __restrict__ kimg,
                   const unsigned char* __restrict__ vimg, const int tile0, const int nlat, u16* __restrict__ out,
                   const int act_lo, const int r, const int qcol0, const float* __restrict__ rpb_h, const float mfix, const float* __restrict__ qg) {
  const int lane = tid & 63, ql = lane & 31, hl = lane >> 5;
  const int nseq = nlat + 4;
  bf16x8 bq[4];
#pragma unroll
  for (int ks = 0; ks < 4; ++ks) bq[ks] = *(const bf16x8*)(q + (size_t)ql * DIN + ks * 16 + hl * 8);
  if (FIXED) q_normrope<false>(bq, qg, nullptr, 0, hl, lane);
  float* btab = (float*)(lds + 65536);
  if (NA) { if (tid < 465) btab[tid] = rpb_h[tid] * 1.4426950408889634f; }
  const unsigned char* kt = kimg + tid * 16;
  const unsigned char* vt = vimg + tid * 16;
  unsigned char* ldst = lds + tid * 16;
#define AT_TILE(i_) ((i_) < nlat ? tile0 + (i_) : 32 + (i_) - nlat)
#define AT_LOAD(i_) do { const int tl_ = AT_TILE(i_); \
    __builtin_amdgcn_global_load_lds((const unsigned*)(kt + (size_t)tl_ * IMG_TILE), (unsigned*)(ldst + ((i_) & 3) * 16384), 16, 0, 0); \
    __builtin_amdgcn_global_load_lds((const unsigned*)(vt + (size_t)tl_ * IMG_TILE), (unsigned*)(ldst + ((i_) & 3) * 16384 + 8192), 16, 0, 0); } while (0)
  AT_LOAD(0); AT_LOAD(1); AT_LOAD(2);
  f32x16 o0, o1;
#pragma unroll
  for (int i = 0; i < 16; ++i) { o0[i] = 0.f; o1[i] = 0.f; }
  float mrun = -1e30f, lsum = 0.f;
  const float cs = 0.125f * 1.4426950408889634f;
  const int swk = (ql >> 1) & 7;
  const int koff = ql * 128;
  const int voff = ql * 128 + hl * 8;
  const int qcol = qcol0 + ql;
  const int w0 = min(max(qcol - 8, 0), 48);
  for (int t = 0; t < nseq; ++t) {
    if (t + 2 < nseq) asm volatile("s_waitcnt vmcnt(4)" ::: "memory");
    else if (t + 1 < nseq) asm volatile("s_waitcnt vmcnt(2)" ::: "memory");
    else asm volatile("s_waitcnt vmcnt(0)" ::: "memory");
    __builtin_amdgcn_s_barrier();
    if (t + 3 < nseq) AT_LOAD(t + 3);
    const int tile = AT_TILE(t);
    const bool latent = t < nlat;
    if (NA && latent && (tile < act_lo || tile >= act_lo + 8)) continue;
    const unsigned char* sk = lds + (t & 3) * 16384;
    const unsigned char* sv = sk + 8192;
#pragma unroll
    for (int s2 = 0; s2 < 2; ++s2) {
      f32x16 sc;
#pragma unroll
      for (int i = 0; i < 16; ++i) sc[i] = 0.f;
#pragma unroll
      for (int ks = 0; ks < 4; ++ks) {
        bf16x8 ak = *(const bf16x8*)(sk + s2 * 4096 + koff + (((ks * 2 + hl) ^ swk) << 4));
        sc = __builtin_amdgcn_mfma_f32_32x32x16_bf16(ak, bq[ks], sc, 0, 0, 0);
      }
      const bool na_far = NA && latent && (s2 != (qcol0 >> 5));
      if (na_far) {
        const float* brow_ = btab + (tile - r + 7) * 31;
        const int kcb = s2 * 32 + hl * 4;
        if (qcol0 == 0) na_softmax<0, 4>(sc, o0, o1, mrun, lsum, brow_, kcb, w0, qcol, cs, lane);
        else na_softmax<12, 16>(sc, o0, o1, mrun, lsum, brow_, kcb, w0, qcol, cs, lane);
      } else {
      if (!FIXED) {
      float tmax;
      if (NA && latent) {
        const float* brow_ = btab + (tile - r + 7) * 31;
        const int kcb = s2 * 32 + hl * 4;
#pragma unroll
        for (int i = 0; i < 16; ++i) {
          int kc = kcb + 8 * (i >> 2) + (i & 3);
          bool valid = (kc >= w0) && (kc < w0 + 16);
          int dx = min(max(kc - qcol, -15), 15) + 15;
          float bv = brow_[dx];
          sc[i] = valid ? sc[i] * cs + bv : -1e30f;
        }
        tmax = fmaxf(fmaxf(sc[0], sc[1]), fmaxf(sc[2], sc[3]));
#pragma unroll
        for (int i = 4; i < 16; i += 4) tmax = fmaxf(tmax, fmaxf(fmaxf(sc[i], sc[i + 1]), fmaxf(sc[i + 2], sc[i + 3])));
      } else {
        tmax = fmaxf(fmaxf(sc[0], sc[1]), fmaxf(sc[2], sc[3]));
#pragma unroll
        for (int i = 4; i < 16; i += 4) tmax = fmaxf(tmax, fmaxf(fmaxf(sc[i], sc[i + 1]), fmaxf(sc[i + 2], sc[i + 3])));
        tmax *= cs;
      }
      tmax = max_x32(tmax);
      if (__builtin_amdgcn_ballot_w64(tmax > mrun + 4.f) != 0ull) {
        const float mnew = fmaxf(mrun, tmax);
        const float alpha = __builtin_amdgcn_exp2f(mrun - mnew);
        mrun = mnew;
        lsum *= alpha;
#pragma unroll
        for (int i = 0; i < 16; ++i) { o0[i] *= alpha; o1[i] *= alpha; }
      }
      }
      {
        const float mref = FIXED ? mfix : mrun;
        const f2_t m2 = {-mref, -mref};
        const f2_t c2 = (NA && latent) ? (f2_t){1.f, 1.f} : (f2_t){cs, cs};
        f2_t ps2 = {0.f, 0.f};
#pragma unroll
        for (int i = 0; i < 16; i += 2) {
          f2_t x = {sc[i], sc[i + 1]};
          x = x * c2 + m2;
          f2_t e = {__builtin_amdgcn_exp2f(x[0]), __builtin_amdgcn_exp2f(x[1])};
          sc[i] = e[0]; sc[i + 1] = e[1];
          ps2 += e;
        }
        lsum += ps2[0] + ps2[1];
      }
      }
#pragma unroll
      for (int kb = 0; kb < 2; ++kb) {
        u32x4 pp;
#pragma unroll
        for (int j = 0; j < 4; ++j) pp[j] = pk2(sc[kb * 8 + 2 * j], sc[kb * 8 + 2 * j + 1]);
        const bf16x8 pb = __builtin_bit_cast(bf16x8, pp);
        u32x4 a0, a1;
        {
          u32x2 x0 = *(const u32x2*)(sv + voff + (((s2 * 4 + kb * 2 + 0) ^ swk) << 4));
          u32x2 x1 = *(const u32x2*)(sv + voff + (((s2 * 4 + kb * 2 + 1) ^ swk) << 4));
          u32x2 y0 = *(const u32x2*)(sv + 4096 + voff + (((s2 * 4 + kb * 2 + 0) ^ swk) << 4));
          u32x2 y1 = *(const u32x2*)(sv + 4096 + voff + (((s2 * 4 + kb * 2 + 1) ^ swk) << 4));
          a0[0] = x0[0]; a0[1] = x0[1]; a0[2] = x1[0]; a0[3] = x1[1];
          a1[0] = y0[0]; a1[1] = y0[1]; a1[2] = y1[0]; a1[3] = y1[1];
        }
        o0 = __builtin_amdgcn_mfma_f32_32x32x16_bf16(__builtin_bit_cast(bf16x8, a0), pb, o0, 0, 0, 0);
        o1 = __builtin_amdgcn_mfma_f32_32x32x16_bf16(__builtin_bit_cast(bf16x8, a1), pb, o1, 0, 0, 0);
      }
    }
  }
#undef AT_LOAD
#undef AT_TILE
  const float ltot = sum_x32(lsum);
  const float inv = 1.f / ltot;
  {
    u32x2 w0_[4], w1_[4];
#pragma unroll
    for (int j = 0; j < 4; ++j) {
      w0_[j][0] = pk2(o0[4 * j] * inv, o0[4 * j + 1] * inv); w0_[j][1] = pk2(o0[4 * j + 2] * inv, o0[4 * j + 3] * inv);
      w1_[j][0] = pk2(o1[4 * j] * inv, o1[4 * j + 1] * inv); w1_[j][1] = pk2(o1[4 * j + 2] * inv, o1[4 * j + 3] * inv);
    }
    store_ot_tile(out + (size_t)ql * DM, w0_, hl);
    store_ot_tile(out + (size_t)ql * DM + 32, w1_, hl);
  }
  asm volatile("s_waitcnt vmcnt(0)" ::: "memory");
  __builtin_amdgcn_s_barrier();
}


DI void gqa_block2(unsigned char* lds, const int tid, const u16* __restrict__ q, const unsigned char* __restrict__ kimg,
                   const unsigned char* __restrict__ vimg, u16* __restrict__ out, const float mfix,
                   const float* __restrict__ qg, const float* __restrict__ tab, const int pos0) {
  const int lane = tid & 63, ql = lane & 31, hl = lane >> 5;
  bf16x8 bq[2][4];
#pragma unroll
  for (int qt = 0; qt < 2; ++qt)
#pragma unroll
    for (int ks = 0; ks < 4; ++ks) bq[qt][ks] = *(const bf16x8*)(q + (size_t)(qt * 32 + ql) * DIN + ks * 16 + hl * 8);
  q_normrope<true>(bq[0], qg, tab, pos0 + ql, hl, lane);
  q_normrope<true>(bq[1], qg, tab, pos0 + 32 + ql, hl, lane);
  const unsigned char* kt = kimg + tid * 16;
  const unsigned char* vt = vimg + tid * 16;
  unsigned char* ldst = lds + tid * 16;
#define G2_LOAD(i_) do { \
    __builtin_amdgcn_global_load_lds((const unsigned*)(kt + (size_t)(i_) * IMG_TILE), (unsigned*)(ldst + ((i_) & 3) * 16384), 16, 0, 0); \
    __builtin_amdgcn_global_load_lds((const unsigned*)(vt + (size_t)(i_) * IMG_TILE), (unsigned*)(ldst + ((i_) & 3) * 16384 + 8192), 16, 0, 0); } while (0)
  G2_LOAD(0); G2_LOAD(1); G2_LOAD(2);
  f32x16 o[2][2];
#pragma unroll
  for (int qt = 0; qt < 2; ++qt)
#pragma unroll
    for (int i = 0; i < 16; ++i) { o[qt][0][i] = 0.f; o[qt][1][i] = 0.f; }
  f2_t ls[2] = {{0.f, 0.f}, {0.f, 0.f}};
  const float cs = 0.125f * 1.4426950408889634f;
  const f2_t c2 = {cs, cs}, m2 = {-mfix, -mfix};
  const int swk = (ql >> 1) & 7;
  const int koff = ql * 128;
  const int voff = ql * 128 + hl * 8;
  for (int t = 0; t < 36; ++t) {
    if (t + 2 < 36) asm volatile("s_waitcnt vmcnt(4)" ::: "memory");
    else if (t + 1 < 36) asm volatile("s_waitcnt vmcnt(2)" ::: "memory");
    else asm volatile("s_waitcnt vmcnt(0)" ::: "memory");
    __builtin_amdgcn_s_barrier();
    if (t + 3 < 36) G2_LOAD(t + 3);
    const unsigned char* sk = lds + (t & 3) * 16384;
    const unsigned char* sv = sk + 8192;
#pragma unroll
    for (int s2 = 0; s2 < 2; ++s2) {
      f32x16 sc[2];
#pragma unroll
      for (int i = 0; i < 16; ++i) { sc[0][i] = 0.f; sc[1][i] = 0.f; }
      bf16x8 ak[4];
#pragma unroll
      for (int ks = 0; ks < 4; ++ks) ak[ks] = *(const bf16x8*)(sk + s2 * 4096 + koff + (((ks * 2 + hl) ^ swk) << 4));
#pragma unroll
      for (int ks = 0; ks < 4; ++ks) sc[0] = __builtin_amdgcn_mfma_f32_32x32x16_bf16(ak[ks], bq[0][ks], sc[0], 0, 0, 0);
#pragma unroll
      for (int ks = 0; ks < 4; ++ks) sc[1] = __builtin_amdgcn_mfma_f32_32x32x16_bf16(ak[ks], bq[1][ks], sc[1], 0, 0, 0);
      u32x4 a0[2], a1[2];
#pragma unroll
      for (int kb = 0; kb < 2; ++kb) {
        const u32x2 x0 = *(const u32x2*)(sv + voff + (((s2 * 4 + kb * 2 + 0) ^ swk) << 4));
        const u32x2 x1 = *(const u32x2*)(sv + voff + (((s2 * 4 + kb * 2 + 1) ^ swk) << 4));
        const u32x2 y0 = *(const u32x2*)(sv + 4096 + voff + (((s2 * 4 + kb * 2 + 0) ^ swk) << 4));
        const u32x2 y1 = *(const u32x2*)(sv + 4096 + voff + (((s2 * 4 + kb * 2 + 1) ^ swk) << 4));
        a0[kb][0] = x0[0]; a0[kb][1] = x0[1]; a0[kb][2] = x1[0]; a0[kb][3] = x1[1];
        a1[kb][0] = y0[0]; a1[kb][1] = y0[1]; a1[kb][2] = y1[0]; a1[kb][3] = y1[1];
      }
#pragma unroll
      for (int qt = 0; qt < 2; ++qt) {
#pragma unroll
        for (int i = 0; i < 16; i += 2) {
          f2_t x = {sc[qt][i], sc[qt][i + 1]};
          x = x * c2 + m2;
          const f2_t e = {__builtin_amdgcn_exp2f(x[0]), __builtin_amdgcn_exp2f(x[1])};
          sc[qt][i] = e[0]; sc[qt][i + 1] = e[1];
          ls[qt] += e;
        }
#pragma unroll
        for (int kb = 0; kb < 2; ++kb) {
          u32x4 pp;
#pragma unroll
          for (int j = 0; j < 4; ++j) pp[j] = pk2(sc[qt][kb * 8 + 2 * j], sc[qt][kb * 8 + 2 * j + 1]);
          const bf16x8 pb = __builtin_bit_cast(bf16x8, pp);
          o[qt][0] = __builtin_amdgcn_mfma_f32_32x32x16_bf16(__builtin_bit_cast(bf16x8, a0[kb]), pb, o[qt][0], 0, 0, 0);
          o[qt][1] = __builtin_amdgcn_mfma_f32_32x32x16_bf16(__builtin_bit_cast(bf16x8, a1[kb]), pb, o[qt][1], 0, 0, 0);
        }
      }
    }
  }
#undef G2_LOAD
#pragma unroll
  for (int qt = 0; qt < 2; ++qt) {
    const float lsum = ls[qt][0] + ls[qt][1];
    const float inv = 1.f / sum_x32(lsum);
    u16* ob = out + (size_t)(qt * 32 + ql) * DM;
    u32x2 w0_[4], w1_[4];
#pragma unroll
    for (int j = 0; j < 4; ++j) {
      w0_[j][0] = pk2(o[qt][0][4 * j] * inv, o[qt][0][4 * j + 1] * inv); w0_[j][1] = pk2(o[qt][0][4 * j + 2] * inv, o[qt][0][4 * j + 3] * inv);
      w1_[j][0] = pk2(o[qt][1][4 * j] * inv, o[qt][1][4 * j + 1] * inv); w1_[j][1] = pk2(o[qt][1][4 * j + 2] * inv, o[qt][1][4 * j + 3] * inv);
    }
    store_ot_tile(ob, w0_, hl);
    store_ot_tile(ob + 32, w1_, hl);
  }
  asm volatile("s_waitcnt vmcnt(0)" ::: "memory");
  __builtin_amdgcn_s_barrier();
}

DI void att_phase(const Params& P, unsigned char* lds, int l, bool last, int wv) {
  const int wave = wv;
  const u16* p = (const u16*)(P.ws + WS_P);
  u16* mix = (u16*)(P.ws + WS_MIX);
  const int bid = get_bid(), G = gridDim.x;
  float mfix;
  {
    const int lane_ = get_tid(wv) & 63;
    float gq = fabsf(P.q_norm_g[l * 64 + lane_]), gk = fabsf(P.k_norm_g[l * 64 + lane_]);
#pragma unroll
    for (int o = 32; o >= 1; o >>= 1) { gq = fmaxf(gq, shx(gq, o, lane_)); gk = fmaxf(gk, shx(gk, o, lane_)); }
    mfix = 8.f * gq * gk * 1.4426950408889634f * 1.03f;
  }
  for (int rep_ = 0; rep_ < ((PROBE_DUP & 32) ? 2 : 1); ++rep_)
  for (int item = bid; item < 256; item += G) {
    const int b = item >> 5, kvh = (item >> 4) & 1, qblk = item & 15;
    const int h = kvh * 4 + (wave >> 1);
    const size_t qrow = (size_t)b * 2048 + qblk * 128 + (wave & 1) * 64;
    gqa_block2(lds, get_tid(wv), p + qrow * DIN + 1024 + h * 64,
               P.ws + WS_KC + (size_t)(b * 2 + kvh) * 36 * IMG_TILE, P.ws + WS_VC + (size_t)(b * 2 + kvh) * 36 * IMG_TILE,
               mix + qrow * DM + 512 + h * 64, mfix, P.q_norm_g + l * 64, (const float*)(P.ws + WS_ROPE), qblk * 128 + (wave & 1) * 64);
  }
  for (int rep_ = 0; rep_ < ((PROBE_DUP & 64) ? 2 : 1); ++rep_)
  for (int item = bid; item < 256; item += G) {
    const int b = item >> 5, h = (item >> 3) & 3, rg = item & 7;
    const int r = rg * 4 + (wave >> 1);
    const int r0 = min(max(r - 4, 0), 24);
    const int u_lo = min(max(rg * 4 - 4, 0), 24), u_hi = min(max(rg * 4 + 3 - 4, 0), 24) + 8;
    const size_t qrow = (size_t)b * 2048 + r * 64 + (wave & 1) * 32;
    attn_block<true, false>(lds, get_tid(wv), p + qrow * DIN + h * 64,
                     P.ws + WS_KA + (size_t)(b * 4 + h) * 36 * IMG_TILE, P.ws + WS_VA + (size_t)(b * 4 + h) * 36 * IMG_TILE,
                     u_lo, u_hi - u_lo, mix + qrow * DM + h * 64, r0, r, (wave & 1) * 32,
                     P.na_rpb + (size_t)(l * 4 + h) * 15 * 31, 0.f, nullptr);
  }
  if (!last) {
    for (int item = bid; item < 96; item += G) {
      if (item < 32) {
        const int b = item >> 2, h = item & 3;
        const size_t qrow = (size_t)M_LAT + b * 256 + wave * 32;
        attn_block<false, false>(lds, get_tid(wv), p + qrow * DIN + h * 64,
                          P.ws + WS_KA + (size_t)(b * 4 + h) * 36 * IMG_TILE, P.ws + WS_VA + (size_t)(b * 4 + h) * 36 * IMG_TILE,
                          0, 0, mix + qrow * DM + h * 64, 0, 0, 0, nullptr, 0.f, nullptr);
      } else {
        const int it2 = item - 32, b = it2 >> 3, h = it2 & 7, kvh = h >> 2;
        const size_t qrow = (size_t)M_LAT + b * 256 + wave * 32;
        attn_block<false, true>(lds, get_tid(wv), p + qrow * DIN + 1024 + h * 64,
                          P.ws + WS_KC + (size_t)(b * 2 + kvh) * 36 * IMG_TILE, P.ws + WS_VC + (size_t)(b * 2 + kvh) * 36 * IMG_TILE,
                          0, 0, mix + qrow * DM + 512 + h * 64, 0, 0, 0, nullptr, mfix, P.q_norm_g + l * 64);
      }
    }
  }
  {
    const int npool = last ? 256 : 288;
    for (int it = (bid + G - (96 % G)) % G; it < npool; it += G) pool_item(P, lds, l, it, get_tid(wv));
  }
}

#define XB_TMO      128
#define XB_XCNT(j)  (256  + 64 * (j))
#define XB_XSUB(j)  (1280 + 64 * (j))
#define XB_XGEN(j)  (2304 + 64 * (j))
#define XB_TOP      3328
#define XB_TOPGEN   3392
#define XB_SPIN_CAP (1u << 22)
#define LAS __attribute__((address_space(3)))
DI unsigned xb_ld(unsigned* p) { return __hip_atomic_load(p, __ATOMIC_RELAXED, __HIP_MEMORY_SCOPE_AGENT); }
DI unsigned xb_add(unsigned* p, unsigned v) { return __hip_atomic_fetch_add(p, v, __ATOMIC_RELAXED, __HIP_MEMORY_SCOPE_AGENT); }
DI unsigned xb_xcc_id() { return (unsigned)__builtin_amdgcn_s_getreg((3 << 11) | 20) & 0xFu; }
#define XB_SPIN(cond, bar) do { unsigned _sp = 0; while (cond) { __builtin_amdgcn_s_sleep(1); \
    if ((++_sp & 255u) == 0u) { if (xb_ld(&(bar)[XB_TMO])) break; if (_sp > XB_SPIN_CAP) { atomicAdd(&(bar)[XB_TMO], 1u); break; } } } } while (0)

DI void xcd_barrier_complete(unsigned* bar, unsigned x, unsigned& nloc, unsigned& nx) {
  const unsigned G = gridDim.x;
  unsigned sum, cnt, mine, sp = 0u;
  for (;;) {
    sum = 0u; cnt = 0u; mine = 0u;
#pragma unroll
    for (unsigned j = 0; j < 16; ++j) { const unsigned c = xb_ld(&bar[XB_XCNT(j)]); sum += c; cnt += (c > 0u) ? 1u : 0u; mine = (j == x) ? c : mine; }
    if (sum == G) break;
    __builtin_amdgcn_s_sleep(1);
    if ((++sp & 255u) == 0u) { if (xb_ld(&bar[XB_TMO])) break; if (sp > XB_SPIN_CAP) { atomicAdd(&bar[XB_TMO], 1u); break; } }
  }
  nloc = mine > 0u ? mine : 1u; nx = cnt > 0u ? cnt : 1u;
}

DI void xcd_barrier(unsigned* bar, const unsigned x, volatile LAS unsigned* st, const int tid) {
  asm volatile("s_waitcnt vmcnt(0)" ::: "memory");
  __syncthreads();
  if (tid == 0) {
    __builtin_amdgcn_s_waitcnt(0);
    unsigned nloc = st[0], nx = st[1];
    if (nloc == 0u) { xcd_barrier_complete(bar, x, nloc, nx); st[0] = nloc; st[1] = nx; }
    const unsigned old = xb_add(&bar[XB_XSUB(x)], 1u);
    const unsigned gen = old / nloc;
    if (old + 1u == (gen + 1u) * nloc) {
      __builtin_amdgcn_fence(__ATOMIC_RELEASE, "agent");
      asm volatile("s_waitcnt vmcnt(0)" ::: "memory");
      const unsigned og = xb_add(&bar[XB_TOP], 1u);
      const unsigned tg = og / nx;
      if (og + 1u == (tg + 1u) * nx) xb_add(&bar[XB_TOPGEN], 1u);
      else XB_SPIN(xb_ld(&bar[XB_TOPGEN]) == tg, bar);
      __builtin_amdgcn_fence(__ATOMIC_ACQUIRE, "agent");
      xb_add(&bar[XB_XGEN(x)], 1u);
      asm volatile("s_waitcnt vmcnt(0)" ::: "memory");
    } else {
      XB_SPIN(xb_ld(&bar[XB_XGEN(x)]) == gen, bar);
      __builtin_amdgcn_fence(__ATOMIC_ACQUIRE, "agent");
      asm volatile("s_waitcnt vmcnt(0)" ::: "memory");
    }
  }
  __syncthreads();
}

DI void drain_bg(const Params& P, unsigned char* lds, const int wv, const int lnext, const int which) {
  unsigned* ctr = (unsigned*)(P.ws + WS_BAR) + 3500 + lnext * 2 + which;
  volatile LAS int* slot = (volatile LAS int*)(lds + LDS_MAIN + 16);
  const int n_items = which == 0 ? 852 : 467;
  for (;;) {
    const int tid = get_tid(wv);
    __syncthreads();
    if (tid == 0) *slot = (int)xb_add(ctr, 1u);
    __syncthreads();
    const int it = *slot;
    if (it >= n_items) break;
    if (which == 0) {
      if (it < 36) p0_mod_item(P, lds, lnext * 36 + it, tid);
      else {
        const int i2 = it - 36;
        const int r = i2 < 352 ? i2 : (i2 < 464 ? 1056 + (i2 - 352) : 528 + (i2 - 464));
        p0_transpose_item(P, lds, lnext, r, tid);
      }
    } else {
      if (it < 416) {
        const int r = it < 176 ? 352 + it : (it < 352 ? 880 + (it - 176) : 1168 + (it - 352));
        p0_transpose_item(P, lds, lnext, r, tid);
      } else sw_item(P, lds, lnext, it - 416, tid);
    }
  }
}

__global__ void __launch_bounds__(512) mega(Params P0) {
  extern __shared__ __attribute__((aligned(16))) unsigned char lds[];
  cg::grid_group grid = cg::this_grid();
  const int wv = __builtin_amdgcn_readfirstlane((int)(threadIdx.x >> 6));
  volatile LAS unsigned* xb_st = (volatile LAS unsigned*)(lds + LDS_MAIN);
  unsigned* xb_bar = (unsigned*)(P0.ws + WS_BAR);
  const unsigned xb_x = xb_xcc_id();
  if (threadIdx.x == 0) { xb_st[0] = 0u; xb_st[1] = 0u; (void)xb_add(&xb_bar[XB_XCNT(xb_x)], 1u); }
  __syncthreads();
  for (int ph = P0.ph_lo; ph < P0.ph_hi; ++ph) {
    Params P = P0;
    {
      __attribute__((address_space(1))) unsigned char* w_ = (__attribute__((address_space(1))) unsigned char*)P0.ws;
      asm volatile("" : "+s"(w_));
      P.ws = (unsigned char*)w_; }
#if PROBE_DUP
    int nrep = 1;
    { const int s_ = (ph == 0) ? 100 : (ph == 1 ? 102 : (ph == NPH - 1 ? 101 : 200));
      if ((PROBE_DUP & 1) && s_ == 4) nrep = 2;
      if ((PROBE_DUP & 2) && (s_ == 0 || s_ == 6)) nrep = 2;
      if ((PROBE_DUP & 4) && s_ == 100) nrep = 2;
      if ((PROBE_DUP & 8) && s_ == 102) nrep = 2;
      if ((PROBE_DUP & 16) && s_ == 2) nrep = 2;
      if ((PROBE_DUP & 256) && (s_ == 1 || s_ == 7)) nrep = 2;
      if ((PROBE_DUP & 512) && s_ == 5) nrep = 2; }
    for (int rep = 0; rep < nrep; ++rep) {
      if (rep) xcd_barrier(xb_bar, xb_x, xb_st, get_tid(wv));
#endif
    if (ph == 0) {
      phase0(P, lds, wv);
    } else if (ph == 1) {
      phase0b(P, lds, wv);
    } else if (ph == NPH - 1) {
      final_phase(P, wv);
    } else {
      const int l = (ph - 2) / 7, s_ = (ph - 2) - l * 7;
      const int s = s_ < 3 ? s_ : s_ + 1;
      const bool last = (l == DEPTH - 1);
      const u16* wt = (const u16*)(P.ws + WS_WT) + (size_t)l * WT_LAYER;
      const float* mod = (const float*)(P.ws + WS_MOD) + (size_t)l * 9 * NMOD;
      float* h = (float*)(P.ws + WS_H);
      const u16* a = (const u16*)(P.ws + WS_A);
      const float* ssp = (const float*)(P.ws + WS_SSP);
      const float* swl = (const float*)(P.ws + WS_SW) + (size_t)l * 3 * 9 * SW_LD;
      if (s == 0 || s == 6) {
        EpiSwiglu E{(u16*)(P.ws + WS_ACT), ssp, s == 0 ? swl : swl + 2 * 9 * SW_LD, (const float*)(lds + LDS_RL), true};
        const u16* B = s == 0 ? wt : wt + WT_UP + WT_DN;
        gemm_phase<1024>(lds, wv, a, B, (last && s == 6) ? M_LAT : M_ALL, 5632, E);
        if (!last) drain_bg(P, lds, wv, l + 1, s == 0 ? 0 : 1);
      } else if (s == 1 || s == 5 || s == 7) {
        EpiResid E;
        const bool fromx = (l == 0 && s == 1);
        E.hin_lat = fromx ? P.x : h;
        E.hin_ctx = fromx ? P.ctx : h + (size_t)M_LAT * DM;
        E.hout = h;
#if PROBE_DUP
        if (rep + 1 < nrep) E.hout = (float*)(P.ws + WS_PROBE);
#endif
        const int gi = s == 1 ? 2 : (s == 5 ? 5 : 8);
        E.gate = mod + gi * 1024;
        E.coef = s == 5 ? 1.f : 0.5f;
        E.do_next = !(last && s == 7);
        E.hg = (u16*)(P.ws + WS_A);
        E.ssp = (float*)(P.ws + WS_SSP);
        E.ssl = (float*)(lds + LDS_SSL);
        if (s == 1) { E.gnext = P.norm_g + (l * 3 + 1) * 1024; E.scnext = mod + 4 * 1024; }
        else if (s == 5) { E.gnext = P.norm_g + (l * 3 + 2) * 1024; E.scnext = mod + 7 * 1024; }
        else { const int ln = last ? l : l + 1; E.gnext = P.norm_g + (ln * 3) * 1024; E.scnext = (const float*)(P.ws + WS_MOD) + (size_t)ln * 9 * NMOD + 1024; }
        const bool do_ctx = !(last && s != 1);
        const u16* Bw = s == 5 ? wt + 2 * WT_UP + 2 * WT_DN + WT_IN : (s == 1 ? wt + WT_UP : wt + 2 * WT_UP + WT_DN);
        const u16* Aop = s == 5 ? (const u16*)(P.ws + WS_MIX) : (const u16*)(P.ws + WS_ACT);
        if (s == 5) gemm_phase<1024>(lds, wv, Aop, Bw, M_LAT, 1024, E);
        else gemm_phase<DFF>(lds, wv, Aop, Bw, M_LAT, 1024, E);
        if (do_ctx) {
          SmallEpi SE;
          SE.hin = fromx ? P.ctx - (size_t)M_LAT * DM : h; SE.hout = E.hout; SE.gate = E.gate + 8 * NMOD; SE.coef = E.coef;
          SE.do_next = E.do_next; SE.hg = E.hg; SE.gnext = E.gnext; SE.scnext = E.scnext + 8 * NMOD;
          SE.sspc = (float*)(P.ws + WS_SSPC); SE.ssl = E.ssl;
          for (int bidx = get_bid(); bidx < 256; bidx += gridDim.x) {
            const int idx = bidx >> 3;
            const int pm = (bidx & 7) * 4 + (idx >> 3), pn = idx & 7;
            if (s == 5) gemm_small_tile<1024>(lds, get_tid(wv), Aop, Bw, M_LAT + pm * 64, pn * 128, SE);
            else gemm_small_tile<DFF>(lds, get_tid(wv), Aop, Bw, M_LAT + pm * 64, pn * 128, SE);
          }
        }
      } else if (s == 2) {
        EpiProj E{(u16*)(P.ws + WS_P), DIN, ssp, swl + 9 * SW_LD, (const float*)(lds + LDS_RL), true, P.ws,
                  P.k_norm_g + l * 64, (const float*)(P.ws + WS_ROPE), (float*)(lds + LDS_SSL)};
        gemm_phase<1024>(lds, wv, a, wt + 2 * WT_UP + 2 * WT_DN, M_ALL, DIN, E);
      } else {
        att_phase(P, lds, l, last, wv);
      }
    }
#if PROBE_DUP
    }
#endif
    if (ph + 1 < P0.ph_hi) {
      if (P0.ph_hi < 0) grid.sync();
      xcd_barrier(xb_bar, xb_x, xb_st, get_tid(wv));
#if (PROBE_DUP & 1024)
      for (int e_ = 0; e_ < 2; ++e_) xcd_barrier(xb_bar, xb_x, xb_st, get_tid(wv));
#endif
    }
  }
}

extern "C" void kernel_launch(void* const* d_in, const int* in_sizes, int n_in, void* d_out, int out_size,
                              void* d_ws, size_t ws_size, hipStream_t stream) {
  static int grid_blocks = 0;
  if (!grid_blocks) {
    if (ws_size < WS_TOTAL + (PROBE_DUP ? (size_t)M_ALL * 1024 * 4 : 0)) { fprintf(stderr, "workspace too small: %zu < %zu\n", ws_size, (size_t)WS_END); grid_blocks = -1; return; }
    int dev = 0, cus = 0, per_cu = 0;
    hipGetDevice(&dev);
    hipDeviceGetAttribute(&cus, hipDeviceAttributeMultiprocessorCount, dev);
    if (hipFuncSetAttribute((const void*)mega, hipFuncAttributeMaxDynamicSharedMemorySize, LDS_BYTES) != hipSuccess)
      fprintf(stderr, "hipFuncSetAttribute failed\n");
    hipOccupancyMaxActiveBlocksPerMultiprocessor(&per_cu, mega, 512, LDS_BYTES);
    if (per_cu < 1) per_cu = 1;
    grid_blocks = cus * per_cu;
    (void)hipGetLastError();
  }
  if (grid_blocks < 0) return;
  hipMemsetAsync((unsigned char*)d_ws + WS_BAR, 0, BAR_BYTES, stream);
  Params p{};
  const float** pp = (const float**)&p;
  for (int i = 0; i < 19; ++i) pp[i] = (const float*)d_in[i];
  p.out = (float*)d_out; p.ws = (unsigned char*)d_ws;
#if MULTI
  for (int ph = 0; ph < NPH; ++ph) {
    p.ph_lo = ph; p.ph_hi = ph + 1;
    hipLaunchKernelGGL(mega, dim3(grid_blocks), dim3(512), LDS_BYTES, stream, p);
  }
#else
  p.ph_lo = 0; p.ph_hi = NPH;
  void* args[] = {&p};
  hipError_t e = hipLaunchCooperativeKernel((void*)mega, dim3(grid_blocks), dim3(512), args, LDS_BYTES, stream);
  if (e != hipSuccess) fprintf(stderr, "cooperative launch failed: %s (grid %d)\n", hipGetErrorString(e), grid_blocks);
#endif
}
```

```cpp
#include <hip/hip_runtime.h>
#include <hip/hip_cooperative_groups.h>
#include <cstdio>
namespace cg = cooperative_groups;

#ifndef MULTI
#define MULTI 0
#endif
#ifndef PROBE_DUP
#define PROBE_DUP 0
#endif

typedef unsigned short u16;
typedef __bf16 bf2_t __attribute__((ext_vector_type(2)));
typedef float f2_t __attribute__((ext_vector_type(2)));
using bf16x8 = __attribute__((ext_vector_type(8))) short;
using f32x4 = __attribute__((ext_vector_type(4))) float;
using f32x16 = __attribute__((ext_vector_type(16))) float;
using f32x4v = __attribute__((ext_vector_type(4))) float;
__device__ __forceinline__ float4 ld_nt4(const float* p) { const f32x4v v = __builtin_nontemporal_load((const f32x4v*)p); return make_float4(v[0], v[1], v[2], v[3]); }
using u32x4 = __attribute__((ext_vector_type(4))) unsigned;
using u32x2 = __attribute__((ext_vector_type(2))) unsigned;

#define DI __device__ __forceinline__
#define LAUNDER_V(x) asm volatile("" : "+v"(x))
#define LAUNDER_S(x) asm volatile("" : "+s"(x))
DI int get_tid(int wv) {
  int t; const int wb = wv << 6;
  asm volatile("v_mbcnt_lo_u32_b32 %0, -1, 0\n\tv_mbcnt_hi_u32_b32 %0, -1, %0\n\tv_or_b32 %0, %1, %0" : "=&v"(t) : "s"(wb));
  return t;
}
DI float shx(float v, int mask, int lane) { return __int_as_float(__builtin_amdgcn_ds_bpermute((lane ^ mask) << 2, __float_as_int(v))); }
DI int get_bid() { int b = blockIdx.x; LAUNDER_S(b); return b; }

DI unsigned pk2(float a, float b) { f2_t v = {a, b}; bf2_t r = __builtin_convertvector(v, bf2_t); return __builtin_bit_cast(unsigned, r); }
DI u16 f2bf(float a) { return (u16)(pk2(a, 0.f) & 0xffffu); }
DI float bf_lo(unsigned u) { return __uint_as_float(u << 16); }
DI float bf_hi(unsigned u) { return __uint_as_float(u & 0xffff0000u); }
DI float bf2f(u16 v) { return __uint_as_float(((unsigned)v) << 16); }

constexpr int DM = 1024, DFF = 2816, DIN = 1792, DEPTH = 4;
constexpr int M_LAT = 16384, M_CTX = 2048, M_ALL = 18432;
constexpr int NMOD = 9216;
constexpr int VT_LD = 2304;

constexpr size_t al256(size_t x) { return (x + 255) & ~(size_t)255; }
constexpr size_t WS_ROPE = 0;
constexpr size_t WS_MOD = 8192;
constexpr size_t MOD_BYTES = (size_t)DEPTH * 9 * NMOD * 4;
constexpr size_t WS_WT = al256(WS_MOD + MOD_BYTES);
constexpr size_t WT_UP = (size_t)5632 * 1024, WT_DN = (size_t)1024 * 2816, WT_IN = (size_t)1792 * 1024, WT_OUT = (size_t)1024 * 1024;
constexpr size_t WT_LAYER = 2 * WT_UP + 2 * WT_DN + WT_IN + WT_OUT;
constexpr size_t WS_H = al256(WS_WT + WT_LAYER * DEPTH * 2);
constexpr size_t WS_A = WS_H + (size_t)M_ALL * 1024 * 4;
constexpr size_t WS_X = WS_A + (size_t)M_ALL * 1024 * 2;
constexpr size_t WS_ACT = WS_X;
constexpr size_t WS_P = WS_X;
constexpr size_t WS_MIX = WS_P + (size_t)M_ALL * DIN * 2;
constexpr size_t IMG_TILE = 8192;
constexpr size_t WS_KA = WS_MIX + (size_t)M_ALL * 1024 * 2;
constexpr size_t WS_VA = WS_KA + (size_t)8 * 4 * 36 * IMG_TILE;
constexpr size_t WS_KC = WS_VA + (size_t)8 * 4 * 36 * IMG_TILE;
constexpr size_t WS_VC = WS_KC + (size_t)8 * 2 * 36 * IMG_TILE;
constexpr size_t WS_END1 = WS_X + (size_t)M_ALL * DFF * 2;
constexpr size_t WS_END2 = WS_VC + (size_t)8 * 2 * 36 * IMG_TILE;
constexpr size_t WS_END = WS_END1 > WS_END2 ? WS_END1 : WS_END2;

constexpr size_t WS_SW = al256(WS_END);
constexpr size_t SW_LD = 5632;
constexpr size_t WS_SSP = WS_SW + (size_t)DEPTH * 3 * 9 * SW_LD * 4;
constexpr size_t WS_SSPC = WS_SSP + (size_t)M_ALL * 4 * 4;
constexpr size_t WS_BAR = al256(WS_SSPC + (size_t)M_CTX * 8 * 4);
constexpr size_t BAR_BYTES = 16384;
constexpr size_t WS_PROBE = WS_BAR + BAR_BYTES;
constexpr size_t WS_TOTAL = WS_BAR + BAR_BYTES;
constexpr int LDS_MAIN = 147456;
constexpr int LDS_SSL = LDS_MAIN + 64;
constexpr int LDS_RL = LDS_SSL + 4096;
constexpr int LDS_PF = LDS_RL + 1024;
constexpr int LDS_BYTES = LDS_PF + 256;
constexpr int NPH = 3 + DEPTH * 7;

struct Params {
  const float *x, *c, *ctx, *c_ctx, *w_ada, *b_ada, *norm_g, *ffn1_up, *ffn1_down, *ffn2_up, *ffn2_down,
      *w_in, *w_out, *na_rpb, *pool_w, *pool_scale, *q_norm_g, *k_norm_g, *final_g;
  float* out;
  unsigned char* ws;
  int ph_lo, ph_hi;
};

constexpr int HT = 128 * 64;

DI int lds_byte(int r, int c) {
  int st = (r >> 4) * 2 + (c >> 5), rr = r & 15, cc = c & 31, ob = rr * 64 + cc * 2;
  return st * 1024 + (ob ^ (((ob >> 9) & 1) << 5));
}
DI void stage_rc(int b, int& R, int& C) {
  int st = b / 1024, sb = b % 1024, swz = sb ^ (((sb >> 9) & 1) << 5);
  R = (st >> 1) * 16 + swz / 64; C = (st & 1) * 32 + (swz % 64) / 2;
}

template <int K, bool HALFM, class Epi>
DI void gemm_tile(unsigned char* lds, const int tid, const u16* __restrict__ A, const u16* __restrict__ Bt, int brow, int bcol, Epi& epi,
                  const bool prefetched, const bool has_next, const int nbrow, const int nbcol) {
  u16* shm = (u16*)lds;
#define SA(b, h) (shm + ((b) * 2 + (h)) * HT)
#define SB(b, h) (shm + (4 + (b) * 2 + (h)) * HT)
#define STAGE(P, BASE, br, kt) do { const char* _gb = (const char*)(BASE) + ((size_t)(br) * (size_t)K + (size_t)(kt) * 64) * 2; \
    const unsigned _m0 = ldsw + (unsigned)((const char*)(P) - (const char*)shm); \
    asm volatile("s_mov_b32 m0, %0\n\ts_nop 0\n\tglobal_load_lds_dwordx4 %2, %4\n\ts_mov_b32 m0, %1\n\ts_nop 0\n\tglobal_load_lds_dwordx4 %3, %4" \
                 :: "s"(_m0), "s"(_m0 + 8192u), "v"(voff0), "v"(voff1), "s"(_gb) : "m0", "memory"); } while (0)
#define LDA(dst, b, h) for (int m = 0; m < 4; ++m) for (int k = 0; k < 2; ++k) \
    dst[m][k] = *reinterpret_cast<const bf16x8*>((char*)SA(b, h) + lds_byte(wr * 64 + m * 16 + fr, k * 32 + fq * 8))
#define LDB(dst, b, h) for (int n = 0; n < 2; ++n) for (int k = 0; k < 2; ++k) \
    dst[n][k] = *reinterpret_cast<const bf16x8*>((char*)SB(b, h) + lds_byte(wc * 32 + n * 16 + fr, k * 32 + fq * 8))
#define MMA(ai, bj, At_, Bt_) do { __builtin_amdgcn_s_setprio(1); \
    for (int m = 0; m < 4; ++m) for (int n = 0; n < 2; ++n) for (int k = 0; k < 2; ++k) \
      acc[ai][bj][m][n] = __builtin_amdgcn_mfma_f32_16x16x32_bf16(Bt_[n][k], At_[m][k], acc[ai][bj][m][n], 0, 0, 0); \
    __builtin_amdgcn_s_setprio(0); } while (0)
#define MMA_H(ai, bj, At_, Bt_) do { if (!HALFM) MMA(ai, bj, At_, Bt_); } while (0)
#define WAIT_V(n) asm volatile("s_waitcnt vmcnt(" #n ")" ::: "memory")
#define WAIT_L(n) asm volatile("s_waitcnt lgkmcnt(" #n ")" ::: "memory")
#define BAR __builtin_amdgcn_s_barrier()
#define SCHED __builtin_amdgcn_sched_barrier(0)
  constexpr int HALF = 128;
  constexpr int AH = HALFM ? 0 : HALF;
  const int tid16 = tid * 16;
  const unsigned ldsw = (unsigned)__builtin_amdgcn_readfirstlane((int)(((unsigned)(size_t)lds) + (unsigned)(tid >> 6) * 1024u));
  unsigned voff0, voff1;
  { int r_, c_; stage_rc(tid16, r_, c_); voff0 = (unsigned)(r_ * K + c_) * 2u;
    stage_rc(tid16 + 8192, r_, c_); voff1 = (unsigned)(r_ * K + c_) * 2u; }
  const int wid = tid >> 6, lane = tid & 63, wr = wid >> 2, wc = wid & 3, fr = lane & 15, fq = lane >> 4;
  f32x4 acc[2][2][4][2];
#pragma unroll
  for (int a = 0; a < 2; ++a)
#pragma unroll
    for (int b = 0; b < 2; ++b)
#pragma unroll
      for (int m = 0; m < 4; ++m)
#pragma unroll
        for (int n = 0; n < 2; ++n) acc[a][b][m][n] = (f32x4){0.f, 0.f, 0.f, 0.f};
  bf16x8 At[4][2], B0[2][2], B1[2][2];
  const int nt = K / 64;
  {
    const char* pfb = (const char*)epi.prefetch_base(brow, bcol);
    if (pfb) {
      const unsigned pm0 = (unsigned)__builtin_amdgcn_readfirstlane((int)((unsigned)(size_t)lds + LDS_PF));
#pragma unroll
      for (int i = 0; i < 4; ++i) {
        const int li = tid + i * 512;
        const unsigned vo = (unsigned)((li >> 3) * DM * 4 + (li & 7) * 128);
        asm volatile("s_mov_b32 m0, %0\n\ts_nop 0\n\tglobal_load_lds_dword %1, %2" :: "s"(pm0), "v"(vo), "s"(pfb) : "m0", "memory");
      }
    }
  }
  const float4 pre_v = epi.pre_load(tid, brow);
  if (!prefetched) {
    STAGE(SB(0, 0), Bt, bcol, 0); STAGE(SA(0, 0), A, brow, 0);
    STAGE(SB(0, 1), Bt, bcol + HALF, 0); STAGE(SA(0, 1), A, brow + AH, 0);
  }
  if (wr == 1) BAR;
  if (!prefetched) WAIT_V(4);
  BAR;
  epi.pre_use(pre_v, tid, lds);
  if (!prefetched) {
    STAGE(SB(1, 0), Bt, bcol, 1); STAGE(SA(1, 0), A, brow, 1); STAGE(SB(1, 1), Bt, bcol + HALF, 1);
    WAIT_V(6);
  }
  BAR;
  for (int t = 0; t < nt - 2; t += 2) {
    LDB(B0, 0, 0); SCHED; LDA(At, 0, 0); STAGE(SA(1, 1), A, brow + AH, t + 1);
    WAIT_L(8); BAR; WAIT_L(0); MMA(0, 0, At, B0); BAR; SCHED;
    LDB(B1, 0, 1); STAGE(SB(0, 0), Bt, bcol, t + 2);
    BAR; WAIT_L(0); MMA(0, 1, At, B1); BAR;
    if (!HALFM) { LDA(At, 0, 1); } STAGE(SA(0, 0), A, brow, t + 2);
    BAR; WAIT_L(0); MMA_H(1, 0, At, B0); BAR; SCHED;
    STAGE(SB(0, 1), Bt, bcol + HALF, t + 2);
    WAIT_V(6); BAR; MMA_H(1, 1, At, B1); BAR;
    LDB(B0, 1, 0); SCHED; LDA(At, 1, 0); STAGE(SA(0, 1), A, brow + AH, t + 2);
    WAIT_L(8); BAR; WAIT_L(0); MMA(0, 0, At, B0); BAR; SCHED;
    LDB(B1, 1, 1); STAGE(SB(1, 0), Bt, bcol, t + 3);
    BAR; WAIT_L(0); MMA(0, 1, At, B1); BAR;
    if (!HALFM) { LDA(At, 1, 1); } STAGE(SA(1, 0), A, brow, t + 3);
    BAR; WAIT_L(0); MMA_H(1, 0, At, B0); BAR; SCHED;
    STAGE(SB(1, 1), Bt, bcol + HALF, t + 3);
    WAIT_V(6); BAR; MMA_H(1, 1, At, B1); BAR;
  }
  { LDB(B0, 0, 0); LDA(At, 0, 0); STAGE(SA(1, 1), A, brow + AH, nt - 1);
    BAR; WAIT_L(0); MMA(0, 0, At, B0); BAR;
    LDB(B1, 0, 1); BAR; WAIT_L(0); MMA(0, 1, At, B1); BAR;
    if (!HALFM) { LDA(At, 0, 1); } WAIT_V(4); BAR; WAIT_L(0); MMA_H(1, 0, At, B0); MMA_H(1, 1, At, B1); BAR; }
  { LDB(B0, 1, 0); LDA(At, 1, 0); WAIT_V(2); BAR; WAIT_L(0); MMA(0, 0, At, B0); BAR;
    LDB(B1, 1, 1); WAIT_V(0); BAR; WAIT_L(0); MMA(0, 1, At, B1); BAR;
    if (!HALFM) { LDA(At, 1, 1); } BAR; WAIT_L(0); MMA_H(1, 0, At, B0); MMA_H(1, 1, At, B1); BAR; }
  if (wr == 0) BAR;
  if (has_next) {
    STAGE(SB(0, 0), Bt, nbcol, 0); STAGE(SA(0, 0), A, nbrow, 0);
    STAGE(SB(0, 1), Bt, nbcol + HALF, 0); STAGE(SA(0, 1), A, nbrow + AH, 0);
    STAGE(SB(1, 0), Bt, nbcol, 1); STAGE(SA(1, 0), A, nbrow, 1); STAGE(SB(1, 1), Bt, nbcol + HALF, 1);
  }
  { int te = tid; LAUNDER_V(te); const int wid_ = te >> 6, lane_ = te & 63;
    epi(acc, brow, bcol, wid_ >> 2, wid_ & 3, lane_ & 15, lane_ >> 4, HALFM ? 1 : 2); }
  WAIT_V(0);
#undef SA
#undef SB
#undef STAGE
#undef LDA
#undef LDB
#undef MMA
#undef MMA_H
}

template <int K, class Epi>
DI void gemm_phase(unsigned char* lds, int wv, const u16* A, const u16* Bt, int M, int N, Epi& epi) {
  const int nM = M >> 8, nN = N >> 8, T = nM * nN;
  const int G = gridDim.x, b = get_bid(), nx = G >> 3;
  const int full = T / G, R = T - full * G;
  const bool half_tail = (R > 0) && (2 * R <= G) && epi.allow_half();
  const int Tmain = half_tail ? full * G : T;
  bool prefetched = false;
  for (int it = 0; it * G < Tmain; ++it) {
    const int L = ((G & 7) == 0) ? (it * 8 + (b & 7)) * nx + (b >> 3) : it * G + b;
    if (L < Tmain) {
      const int grp = L / (4 * nN), rem = L - grp * (4 * nN);
      const int gm = min(4, nM - grp * 4);
      const int pm = grp * 4 + rem % gm, pn = rem / gm;
      const int L2 = ((G & 7) == 0) ? ((it + 1) * 8 + (b & 7)) * nx + (b >> 3) : (it + 1) * G + b;
      const bool has_next = L2 < Tmain;
      int pm2 = 0, pn2 = 0;
      if (has_next) { const int grp2 = L2 / (4 * nN), rem2 = L2 - grp2 * (4 * nN); const int gm2 = min(4, nM - grp2 * 4); pm2 = grp2 * 4 + rem2 % gm2; pn2 = rem2 / gm2; }
      gemm_tile<K, false>(lds, get_tid(wv), A, Bt, pm * 256, pn * 256, epi, prefetched, has_next, pm2 * 256, pn2 * 256);
      prefetched = has_next;
    }
  }
  if (half_tail && b < 2 * R) {
    const int L = full * G + (b >> 1);
    const int grp = L / (4 * nN), rem = L - grp * (4 * nN);
    const int gm = min(4, nM - grp * 4);
    const int pm = grp * 4 + rem % gm, pn = rem / gm;
    gemm_tile<K, true>(lds, get_tid(wv), A, Bt, pm * 256 + (b & 1) * 128, pn * 256, epi, false, false, 0, 0);
  }
}

struct SmallEpi {
  const float* hin; float* hout; const float* gate; float coef;
  bool do_next; u16* hg; const float* gnext; const float* scnext; float* sspc; float* ssl;
};
template <int K>
DI void gemm_small_tile(unsigned char* lds, const int tid, const u16* __restrict__ A, const u16* __restrict__ Bt,
                        const int row0, const int col0, const SmallEpi& E) {
  const int wave = tid >> 6, lane = tid & 63, ql = lane & 31, hl = lane >> 5;
  const int wm = wave >> 2, wn = wave & 3;
  constexpr int NT = K / 64;
  const int grow = tid >> 3, gc = (tid & 7) ^ ((grow >> 1) & 7);
  const unsigned voff = (unsigned)(grow * K + gc * 8) * 2u;
  const char* ga = (const char*)(A + (size_t)row0 * K) + voff;
  const char* gb = (const char*)(Bt + (size_t)col0 * K) + voff;
  unsigned char* ldst = lds + tid * 16;
#define SM_LOAD(t_, st_) do { \
    __builtin_amdgcn_global_load_lds((const unsigned*)(ga + (size_t)(t_) * 128), (unsigned*)(ldst + (st_) * 24576), 16, 0, 0); \
    __builtin_amdgcn_global_load_lds((const unsigned*)(gb + (size_t)(t_) * 128), (unsigned*)(ldst + (st_) * 24576 + 8192), 16, 0, 0); \
    __builtin_amdgcn_global_load_lds((const unsigned*)(gb + (size_t)64 * K * 2 + (size_t)(t_) * 128), (unsigned*)(ldst + (st_) * 24576 + 16384), 16, 0, 0); } while (0)
  SM_LOAD(0, 0); SM_LOAD(1, 1); SM_LOAD(2, 2); SM_LOAD(3, 3); SM_LOAD(4, 4);
  f32x16 acc;
#pragma unroll
  for (int i = 0; i < 16; ++i) acc[i] = 0.f;
  const int swk = (ql >> 1) & 7;
  const int aoff = (wm * 32 + ql) * 128, boff = 8192 + (wn * 32 + ql) * 128;
  int stc = 0, stl = 5;
  for (int t = 0; t < NT; ++t) {
    if (t + 4 < NT) asm volatile("s_waitcnt vmcnt(12)" ::: "memory");
    else if (t + 3 < NT) asm volatile("s_waitcnt vmcnt(9)" ::: "memory");
    else if (t + 2 < NT) asm volatile("s_waitcnt vmcnt(6)" ::: "memory");
    else if (t + 1 < NT) asm volatile("s_waitcnt vmcnt(3)" ::: "memory");
    else asm volatile("s_waitcnt vmcnt(0)" ::: "memory");
    __builtin_amdgcn_s_barrier();
    if (t + 5 < NT) SM_LOAD(t + 5, stl);
    const unsigned char* st = lds + stc * 24576;
    stc = (stc == 5) ? 0 : stc + 1; stl = (stl == 5) ? 0 : stl + 1;
#pragma unroll
    for (int ks = 0; ks < 4; ++ks) {
      const bf16x8 af = *(const bf16x8*)(st + aoff + (((ks * 2 + hl) ^ swk) << 4));
      const bf16x8 bf = *(const bf16x8*)(st + boff + (((ks * 2 + hl) ^ swk) << 4));
      acc = __builtin_amdgcn_mfma_f32_32x32x16_bf16(af, bf, acc, 0, 0, 0);
    }
  }
#undef SM_LOAD
  const int col = col0 + wn * 32 + ql;
  const float gv = E.gate[col] * E.coef;
  const float gm = E.do_next ? E.gnext[col] * (1.f + E.scnext[col]) : 0.f;
  float hv[16];
#pragma unroll
  for (int i = 0; i < 16; ++i) {
    const int row = row0 + wm * 32 + 8 * (i >> 2) + 4 * hl + (i & 3);
    hv[i] = E.hin[(size_t)row * DM + col];
  }
#pragma unroll
  for (int i = 0; i < 16; ++i) {
    const int rloc = wm * 32 + 8 * (i >> 2) + 4 * hl + (i & 3);
    const size_t o = (size_t)(row0 + rloc) * DM + col;
    const float hn = hv[i] + gv * acc[i];
    E.hout[o] = hn;
    if (E.do_next) {
      E.hg[o] = f2bf(hn * gm);
      float sq = hn * hn;
      sq += shx(sq, 1, lane); sq += shx(sq, 2, lane); sq += shx(sq, 4, lane); sq += shx(sq, 8, lane); sq += shx(sq, 16, lane);
      if (ql == 0) E.ssl[wn * 64 + rloc] = sq;
    }
  }
  if (E.do_next) {
    __syncthreads();
    if (tid < 64) E.sspc[(size_t)(row0 - M_LAT + tid) * 8 + (col0 >> 7)] = (E.ssl[tid] + E.ssl[64 + tid]) + (E.ssl[128 + tid] + E.ssl[192 + tid]);
  }
  asm volatile("s_waitcnt vmcnt(0)" ::: "memory");
  __builtin_amdgcn_s_barrier();
}

DI float4 ld4(const float* p) { return *(const float4*)p; }
DI float silu_mul(float a, float b) { return a * b * __builtin_amdgcn_rcpf(1.f + __builtin_amdgcn_exp2f(a * -1.4426950408889634f)); }


DI void store_nn16(u16* __restrict__ blk0, const u32x2 a, const u32x2 b, const int fq) {
  const auto s0 = __builtin_amdgcn_permlane16_swap(a[0], b[0], false, false);
  const auto s1 = __builtin_amdgcn_permlane16_swap(a[1], b[1], false, false);
  u32x4 v; v[0] = s0[0]; v[1] = s1[0]; v[2] = s0[1]; v[3] = s1[1];
  *(u32x4*)(blk0 + (fq & 1) * 16 + (fq >> 1) * 8) = v;
}
struct EpiSwiglu {
  u16* act;
  const float* ssp;
  const float* sw;
  const float* rl;
  bool ctx8;
  DI bool allow_half() const { return true; }
  DI const float* prefetch_base(int, int) const { return nullptr; }
  DI float4 pre_load(int tid, int brow) const {
    if (brow < M_LAT || !ctx8) return *(const float4*)(ssp + (size_t)(brow + (tid & 255)) * 4);
    const float* q_ = ssp + (size_t)M_ALL * 4 + (size_t)(brow - M_LAT + (tid & 255)) * 8;
    const float4 a_ = *(const float4*)q_, b_ = *(const float4*)(q_ + 4);
    return make_float4(a_.x + b_.x, a_.y + b_.y, a_.z + b_.z, a_.w + b_.w);
  }
  DI void pre_use(const float4& pp, int tid, unsigned char* lds) const {
    if (tid < 256) ((float*)(lds + LDS_RL))[tid] = rsqrtf((pp.x + pp.y + pp.z + pp.w) * (1.f / 1024.f) + 1e-6f);
  }
  DI void operator()(f32x4 (&acc)[2][2][4][2], int brow, int bcol, int wr, int wc, int fr, int fq, const int nai) const {
    const int bi = brow < M_LAT ? (brow >> 11) : 8;
    const float* swr = sw + bi * SW_LD + bcol + wc * 32 + fq * 4;
    const float4 sa0 = ld4(swr), sa1 = ld4(swr + 16), sb0 = ld4(swr + 128), sb1 = ld4(swr + 144);
    u16* ob = act + (size_t)(brow + wr * 64 + fr) * DFF + (bcol >> 1) + wc * 32;
#pragma unroll
    for (int ai = 0; ai < 2; ++ai)
     if (ai < nai)
#pragma unroll
      for (int m = 0; m < 4; ++m) {
        const float r = rl[ai * 128 + wr * 64 + m * 16 + fr];
        u16* o_ = ob + (size_t)(ai * 128 + m * 16) * DFF;
        u32x2 p0, p1;
        {
          const f32x4 a = acc[ai][0][m][0], b = acc[ai][1][m][0];
          p0[0] = pk2(silu_mul(a[0] * r + sa0.x, b[0] * r + sb0.x), silu_mul(a[1] * r + sa0.y, b[1] * r + sb0.y));
          p0[1] = pk2(silu_mul(a[2] * r + sa0.z, b[2] * r + sb0.z), silu_mul(a[3] * r + sa0.w, b[3] * r + sb0.w));
        }
        {
          const f32x4 a = acc[ai][0][m][1], b = acc[ai][1][m][1];
          p1[0] = pk2(silu_mul(a[0] * r + sa1.x, b[0] * r + sb1.x), silu_mul(a[1] * r + sa1.y, b[1] * r + sb1.y));
          p1[1] = pk2(silu_mul(a[2] * r + sa1.z, b[2] * r + sb1.z), silu_mul(a[3] * r + sa1.w, b[3] * r + sb1.w));
        }
        store_nn16(o_, p0, p1, fq);
      }
  }
};

struct EpiBf16 {
  u16* out; int ld;
  const float* ssp;
  const float* sw;
  const float* rl;
  bool ctx8;
  DI bool allow_half() const { return true; }
  DI const float* prefetch_base(int, int) const { return nullptr; }
  DI float4 pre_load(int tid, int brow) const {
    if (brow < M_LAT || !ctx8) return *(const float4*)(ssp + (size_t)(brow + (tid & 255)) * 4);
    const float* q_ = ssp + (size_t)M_ALL * 4 + (size_t)(brow - M_LAT + (tid & 255)) * 8;
    const float4 a_ = *(const float4*)q_, b_ = *(const float4*)(q_ + 4);
    return make_float4(a_.x + b_.x, a_.y + b_.y, a_.z + b_.z, a_.w + b_.w);
  }
  DI void pre_use(const float4& pp, int tid, unsigned char* lds) const {
    if (tid < 256) ((float*)(lds + LDS_RL))[tid] = rsqrtf((pp.x + pp.y + pp.z + pp.w) * (1.f / 1024.f) + 1e-6f);
  }
  DI void operator()(f32x4 (&acc)[2][2][4][2], int brow, int bcol, int wr, int wc, int fr, int fq, const int nai) const {
    const int bi = brow < M_LAT ? (brow >> 11) : 8;
    const float* swr = sw + bi * SW_LD + bcol + wc * 32 + fq * 4;
    float4 sv[2][2];
    sv[0][0] = ld4(swr); sv[0][1] = ld4(swr + 16); sv[1][0] = ld4(swr + 128); sv[1][1] = ld4(swr + 144);
    u16* ob = out + (size_t)(brow + wr * 64 + fr) * ld + bcol + wc * 32 + fq * 4;
#pragma unroll
    for (int ai = 0; ai < 2; ++ai)
     if (ai < nai)
#pragma unroll
      for (int m = 0; m < 4; ++m) {
        const float r = rl[ai * 128 + wr * 64 + m * 16 + fr];
        u16* o_ = ob + (size_t)(ai * 128 + m * 16) * ld;
#pragma unroll
        for (int bj = 0; bj < 2; ++bj)
#pragma unroll
          for (int n = 0; n < 2; ++n) {
            const f32x4 a = acc[ai][bj][m][n];
            const float4 s4 = sv[bj][n];
            u32x2 pk; pk[0] = pk2(a[0] * r + s4.x, a[1] * r + s4.y); pk[1] = pk2(a[2] * r + s4.z, a[3] * r + s4.w);
            *(u32x2*)(o_ + bj * 128 + n * 16) = pk;
          }
      }
  }
};


DI void store_kimg16(unsigned char* __restrict__ rowp, const u32x2 a, const u32x2 b, const int fq, const int cbase, const int swz) {
  const auto s0 = __builtin_amdgcn_permlane16_swap(a[0], b[0], false, false);
  const auto s1 = __builtin_amdgcn_permlane16_swap(a[1], b[1], false, false);
  u32x4 v; v[0] = s0[0]; v[1] = s1[0]; v[2] = s0[1]; v[3] = s1[1];
  const int chunk = cbase + (fq & 1) * 2 + (fq >> 1);
  *(u32x4*)(rowp + ((chunk ^ swz) << 4)) = v;
}
struct EpiProj {
  u16* out; int ld;
  const float* ssp;
  const float* sw;
  const float* rl;
  bool ctx8;
  unsigned char* ws;
  const float* kg;
  const float* tab;
  float* ssl;
  DI bool allow_half() const { return false; }
  DI const float* prefetch_base(int, int) const { return nullptr; }
  DI float4 pre_load(int tid, int brow) const {
    if (brow < M_LAT || !ctx8) return *(const float4*)(ssp + (size_t)(brow + (tid & 255)) * 4);
    const float* q_ = ssp + (size_t)M_ALL * 4 + (size_t)(brow - M_LAT + (tid & 255)) * 8;
    const float4 a_ = *(const float4*)q_, b_ = *(const float4*)(q_ + 4);
    return make_float4(a_.x + b_.x, a_.y + b_.y, a_.z + b_.z, a_.w + b_.w);
  }
  DI void pre_use(const float4& pp, int tid, unsigned char* lds) const {
    if (tid < 256) ((float*)(lds + LDS_RL))[tid] = rsqrtf((pp.x + pp.y + pp.z + pp.w) * (1.f / 1024.f) + 1e-6f);
  }
  DI void keyof(int row, int& b, int& keypos) const {
    if (row < M_LAT) { b = row >> 11; keypos = row & 2047; } else { const int rc = row - M_LAT; b = rc >> 8; keypos = 2048 + (rc & 255); }
  }
  DI void operator()(f32x4 (&acc)[2][2][4][2], int brow, int bcol, int wr, int wc, int fr, int fq, const int nai) const {
    const int bi = brow < M_LAT ? (brow >> 11) : 8;
    const int pn = bcol >> 8;
    const int lane = fq * 16 + fr;
    const float* swr = sw + bi * SW_LD + bcol + wc * 32 + fq * 4;
    float4 sv[2][2];
    sv[0][0] = ld4(swr); sv[0][1] = ld4(swr + 16); sv[1][0] = ld4(swr + 128); sv[1][1] = ld4(swr + 144);
#pragma unroll
    for (int ai = 0; ai < 2; ++ai)
#pragma unroll
      for (int m = 0; m < 4; ++m) {
        const float r = rl[ai * 128 + wr * 64 + m * 16 + fr];
#pragma unroll
        for (int bj = 0; bj < 2; ++bj)
#pragma unroll
          for (int n = 0; n < 2; ++n) {
            f32x4 a = acc[ai][bj][m][n];
            const float4 s4 = sv[bj][n];
            a[0] = a[0] * r + s4.x; a[1] = a[1] * r + s4.y; a[2] = a[2] * r + s4.z; a[3] = a[3] * r + s4.w;
            acc[ai][bj][m][n] = a;
          }
      }
    if (pn == 0 || (pn >= 3 && pn <= 5)) {
      u16* ob = out + (size_t)(brow + wr * 64 + fr) * ld + bcol + wc * 32;
#pragma unroll
      for (int ai = 0; ai < 2; ++ai)
#pragma unroll
        for (int m = 0; m < 4; ++m)
#pragma unroll
          for (int bj = 0; bj < 2; ++bj) {
            const f32x4 a = acc[ai][bj][m][0], b = acc[ai][bj][m][1];
            u32x2 p0, p1; p0[0] = pk2(a[0], a[1]); p0[1] = pk2(a[2], a[3]); p1[0] = pk2(b[0], b[1]); p1[1] = pk2(b[2], b[3]);
            store_nn16(ob + (size_t)(ai * 128 + m * 16) * ld + bj * 128, p0, p1, fq);
          }
      return;
    }
    const int hsub = wc >> 1;
    const int dbase = (wc & 1) * 32 + fq * 4;
    if (pn == 6) {
#pragma unroll
      for (int ai = 0; ai < 2; ++ai)
#pragma unroll
        for (int m = 0; m < 4; ++m) {
          const f32x4 a0 = acc[ai][0][m][0], a1 = acc[ai][0][m][1];
          float sq = a0[0] * a0[0] + a0[1] * a0[1] + a0[2] * a0[2] + a0[3] * a0[3] + a1[0] * a1[0] + a1[1] * a1[1] + a1[2] * a1[2] + a1[3] * a1[3];
          sq += shx(sq, 16, lane); sq += shx(sq, 32, lane);
          if (fq == 0) ssl[wc * 256 + ai * 128 + wr * 64 + m * 16 + fr] = sq;
        }
      __syncthreads();
      const float4 g0 = ld4(kg + dbase), g1 = ld4(kg + dbase + 16);
#pragma unroll
      for (int ai = 0; ai < 2; ++ai)
#pragma unroll
        for (int m = 0; m < 4; ++m) {
          const int rloc = ai * 128 + wr * 64 + m * 16 + fr;
          const int row = brow + rloc;
          const float rs = rsqrtf((ssl[wc * 256 + rloc] + ssl[(wc ^ 1) * 256 + rloc]) * (1.f / 64.f) + 1e-6f);
          f32x4 y1 = acc[ai][0][m][0], y2 = acc[ai][0][m][1];
          y1[0] *= rs * g0.x; y1[1] *= rs * g0.y; y1[2] *= rs * g0.z; y1[3] *= rs * g0.w;
          y2[0] *= rs * g1.x; y2[1] *= rs * g1.y; y2[2] *= rs * g1.z; y2[3] *= rs * g1.w;
          if (row < M_LAT) {
            const int pos = row & 2047;
            const float* tp = tab + (((wc & 1) ? (pos & 63) : (pos >> 6)) * 16 + fq * 4) * 2;
            const float4 c01 = ld4(tp), c23 = ld4(tp + 4);
            float t_;
            t_ = y1[0] * c01.x - y2[0] * c01.y; y2[0] = y1[0] * c01.y + y2[0] * c01.x; y1[0] = t_;
            t_ = y1[1] * c01.z - y2[1] * c01.w; y2[1] = y1[1] * c01.w + y2[1] * c01.z; y1[1] = t_;
            t_ = y1[2] * c23.x - y2[2] * c23.y; y2[2] = y1[2] * c23.y + y2[2] * c23.x; y1[2] = t_;
            t_ = y1[3] * c23.z - y2[3] * c23.w; y2[3] = y1[3] * c23.w + y2[3] * c23.z; y1[3] = t_;
          }
          int b, keypos; keyof(row, b, keypos);
          const int key = keypos & 63, swz = (key >> 1) & 7;
          unsigned char* img = ws + WS_KC + ((size_t)((b * 2 + hsub) * 36 + (keypos >> 6))) * IMG_TILE + key * 128;
          u32x2 p1, p2; p1[0] = pk2(y1[0], y1[1]); p1[1] = pk2(y1[2], y1[3]); p2[0] = pk2(y2[0], y2[1]); p2[1] = pk2(y2[2], y2[3]);
          store_kimg16(img, p1, p2, fq, (wc & 1) * 4, swz);
        }
    }
    if (pn == 1) {
#pragma unroll
      for (int ai = 0; ai < 2; ++ai)
#pragma unroll
        for (int m = 0; m < 4; ++m) {
          const int row = brow + ai * 128 + wr * 64 + m * 16 + fr;
          int b, keypos; keyof(row, b, keypos);
          const int key = keypos & 63, swz = (key >> 1) & 7;
          const int c0 = (wc & 1) * 4 + (fq >> 1);
#pragma unroll
          for (int bj = 0; bj < 2; ++bj) {
            unsigned char* img = ws + WS_KA + ((size_t)((b * 4 + bj * 2 + hsub) * 36 + (keypos >> 6))) * IMG_TILE + key * 128;
            const f32x4 a = acc[ai][bj][m][0], bb_ = acc[ai][bj][m][1];
            u32x2 p0, p1; p0[0] = pk2(a[0], a[1]); p0[1] = pk2(a[2], a[3]); p1[0] = pk2(bb_[0], bb_[1]); p1[1] = pk2(bb_[2], bb_[3]);
            store_kimg16(img, p0, p1, fq, (wc & 1) * 4, swz);
          }
        }
    }
    if (pn == 2 || pn == 6) {
#pragma unroll
      for (int ai = 0; ai < 2; ++ai)
#pragma unroll
        for (int m = 0; m < 4; ++m) {
          const int row = brow + ai * 128 + wr * 64 + m * 16 + fr;
          int b, keypos; keyof(row, b, keypos);
          const int key = keypos & 63;
#pragma unroll
          for (int bj = 0; bj < 2; ++bj) {
            if (pn == 6 && bj == 0) continue;
            unsigned char* img = (pn == 2 ? ws + WS_VA + ((size_t)((b * 4 + bj * 2 + hsub) * 36 + (keypos >> 6))) * IMG_TILE
                                          : ws + WS_VC + ((size_t)((b * 2 + hsub) * 36 + (keypos >> 6))) * IMG_TILE) + (key & 7) * 2;
#pragma unroll
            for (int n = 0; n < 2; ++n) {
              const f32x4 a = acc[ai][bj][m][n];
#pragma unroll
              for (int j = 0; j < 4; ++j) {
                const int d = dbase + n * 16 + j;
                *(u16*)(img + d * 128 + ((((key >> 3)) ^ ((d >> 1) & 7)) << 4)) = f2bf(a[j]);
              }
            }
          }
        }
    }
  }
};

struct EpiResid {
  const float* hin_lat;
  const float* hin_ctx;
  float* hout;
  const float* gate;
  float coef;
  bool do_next;
  u16* hg;
  const float* gnext;
  const float* scnext;
  float* ssp;
  float* ssl;
  DI bool allow_half() const { return false; }
  DI const float* prefetch_base(int brow, int bcol) const { return (brow < M_LAT ? hin_lat : hin_ctx - (size_t)M_LAT * DM) + (size_t)brow * DM + bcol; }
  DI float4 pre_load(int tid, int) const { const float z = (float)tid; return make_float4(z, z, z, z); }
  DI void pre_use(const float4&, int, unsigned char*) const {}
  DI void operator()(f32x4 (&acc)[2][2][4][2], int brow, int bcol, int wr, int wc, int fr, int fq, const int nai) const {
    const int bi = brow < M_LAT ? (brow >> 11) : 8;
    const float* hin = brow < M_LAT ? hin_lat : hin_ctx - (size_t)M_LAT * DM;
    const float* g = gate + bi * NMOD;
    const int lane = fq * 16 + fr;
    const int c0 = bcol + wc * 32 + fq * 4;
    float4 gv[2][2], gm[2][2];
#pragma unroll
    for (int bj = 0; bj < 2; ++bj)
#pragma unroll
      for (int n = 0; n < 2; ++n) {
        const int col = c0 + bj * 128 + n * 16;
        float4 t_ = ld4(g + col);
        gv[bj][n] = make_float4(t_.x * coef, t_.y * coef, t_.z * coef, t_.w * coef);
        if (do_next) {
          const float4 gg = ld4(gnext + col), sc = ld4(scnext + bi * NMOD + col);
          gm[bj][n] = make_float4(gg.x * (1.f + sc.x), gg.y * (1.f + sc.y), gg.z * (1.f + sc.z), gg.w * (1.f + sc.w));
        } else gm[bj][n] = gv[bj][n];
      }
#pragma unroll
    for (int aim = 0; aim < 4; ++aim) {
      const int ai = aim >> 1, mh = (aim & 1) * 2;
      float4 t[2][2][2];
#pragma unroll
      for (int m2 = 0; m2 < 2; ++m2) {
        const float* hi_ = hin + (size_t)(brow + ai * 128 + wr * 64 + (mh + m2) * 16 + fr) * DM + c0;
#pragma unroll
        for (int bj = 0; bj < 2; ++bj)
#pragma unroll
          for (int n = 0; n < 2; ++n) t[m2][bj][n] = ld4(hi_ + bj * 128 + n * 16);
      }
#pragma unroll
      for (int m2 = 0; m2 < 2; ++m2) {
        const int m = mh + m2;
        const int rloc = ai * 128 + wr * 64 + m * 16 + fr;
        float* ho_ = hout + (size_t)(brow + rloc) * DM + c0;
        u16* hg_ = hg + (size_t)(brow + rloc) * DM + bcol + wc * 32;
        u32x2 hpk[2];
        float sq = 0.f;
#pragma unroll
        for (int bj = 0; bj < 2; ++bj)
#pragma unroll
          for (int n = 0; n < 2; ++n) {
            const f32x4 a = acc[ai][bj][m][n];
            const float4 gvv = gv[bj][n];
            float4 hn = t[m2][bj][n];
            hn.x += gvv.x * a[0]; hn.y += gvv.y * a[1]; hn.z += gvv.z * a[2]; hn.w += gvv.w * a[3];
            *(float4*)(ho_ + bj * 128 + n * 16) = hn;
            if (do_next) {
              sq += hn.x * hn.x + hn.y * hn.y + hn.z * hn.z + hn.w * hn.w;
              const float4 gmm = gm[bj][n];
              hpk[n][0] = pk2(hn.x * gmm.x, hn.y * gmm.y); hpk[n][1] = pk2(hn.z * gmm.z, hn.w * gmm.w);
              if (n == 1) store_nn16(hg_ + bj * 128, hpk[0], hpk[1], fq);
            }
          }
        if (do_next) {
          sq += shx(sq, 16, lane); sq += shx(sq, 32, lane);
          if (fq == 0) ssl[wc * 256 + rloc] = sq;
        }
      }
      __builtin_amdgcn_sched_barrier(0);
    }
    if (do_next) {
      __syncthreads();
      const int tid_ = (wr * 4 + wc) * 64 + lane;
      if (tid_ < 256) ssp[(size_t)(brow + tid_) * 4 + (bcol >> 8)] = (ssl[tid_] + ssl[256 + tid_]) + (ssl[512 + tid_] + ssl[768 + tid_]);
    }
  }
};

DI void p0_transpose_item(const Params& P, unsigned char* lds, int l, int r, const int tid) {
  u16* wt = (u16*)(P.ws + WS_WT) + (size_t)l * WT_LAYER;
  const float* src; u16* dst; int K, N, perm = 0;
  if (r < 352) { src = P.ffn1_up + (size_t)l * 1024 * 5632; K = 1024; N = 5632; dst = wt; perm = 1; }
  else if (r < 528) { r -= 352; src = P.ffn1_down + (size_t)l * 2816 * 1024; K = 2816; N = 1024; dst = wt + WT_UP; }
  else if (r < 880) { r -= 528; src = P.ffn2_up + (size_t)l * 1024 * 5632; K = 1024; N = 5632; dst = wt + WT_UP + WT_DN; perm = 1; }
  else if (r < 1056) { r -= 880; src = P.ffn2_down + (size_t)l * 2816 * 1024; K = 2816; N = 1024; dst = wt + 2 * WT_UP + WT_DN; }
  else if (r < 1168) { r -= 1056; src = P.w_in + (size_t)l * 1024 * DIN; K = 1024; N = DIN; dst = wt + 2 * WT_UP + 2 * WT_DN; }
  else { r -= 1168; src = P.w_out + (size_t)l * 1024 * 1024; K = 1024; N = 1024; dst = wt + 2 * WT_UP + 2 * WT_DN + WT_IN; }
  const int nN = N >> 8;
  const int kt = r / nN, ntl = r - kt * nN;
  const int k0 = kt * 64, n0 = ntl * 256;
  float* T = (float*)lds;
  float4 v[8];
#pragma unroll
  for (int i = 0; i < 8; ++i) {
    const int idx = tid + i * 512, k = idx >> 6, n4 = idx & 63;
    v[i] = ld_nt4(src + (size_t)(k0 + k) * N + n0 + n4 * 4);
  }
#pragma unroll
  for (int i = 0; i < 8; ++i) {
    const int idx = tid + i * 512, k = idx >> 6, n4 = idx & 63;
    *(float4*)(T + k * 260 + ((n4 ^ (k >> 3)) << 2)) = v[i];
  }
  __syncthreads();
#pragma unroll
  for (int i = 0; i < 4; ++i) {
    const int idx = tid + i * 512, n = idx >> 3, c = idx & 7;
    float e[8];
#pragma unroll
    for (int j = 0; j < 8; ++j) e[j] = T[(c * 8 + j) * 260 + ((((n >> 2) ^ c)) << 2) + (n & 3)];
    u32x4 o; o[0] = pk2(e[0], e[1]); o[1] = pk2(e[2], e[3]); o[2] = pk2(e[4], e[5]); o[3] = pk2(e[6], e[7]);
    const int ng = n0 + n;
    int drow = ng;
    if (perm) drow = (ng < DFF) ? ((ng >> 7) * 256 + (ng & 127)) : ((((ng - DFF) >> 7) * 256) + 128 + ((ng - DFF) & 127));
    *(u32x4*)(dst + (size_t)drow * K + k0 + c * 8) = o;
  }
  __syncthreads();
}

DI void p0_mod_item(const Params& P, unsigned char* lds, int idx, const int tid) {
  const int wave = tid >> 6, lane = tid & 63;
  const int l = idx / 36, cch = idx - l * 36;
  float* sl = (float*)lds;
  float* red = sl + 9 * 1024;
  for (int i = tid; i < 9 * 1024; i += 512) {
    int r = i >> 10, k = i & 1023;
    float cv = r < 8 ? P.c[r * 1024 + k] : P.c_ctx[k];
    sl[i] = cv / (1.f + expf(-cv));
  }
  __syncthreads();
  float4 acc[9];
#pragma unroll
  for (int r = 0; r < 9; ++r) acc[r] = make_float4(0.f, 0.f, 0.f, 0.f);
  const float* W = P.w_ada + ((size_t)l * 1024 + wave * 128) * NMOD + cch * 256 + lane * 4;
  for (int k4 = 0; k4 < 32; ++k4) {
    float4 w0 = ld_nt4(W + (size_t)(k4 * 4 + 0) * NMOD);
    float4 w1 = ld_nt4(W + (size_t)(k4 * 4 + 1) * NMOD);
    float4 w2 = ld_nt4(W + (size_t)(k4 * 4 + 2) * NMOD);
    float4 w3 = ld_nt4(W + (size_t)(k4 * 4 + 3) * NMOD);
#pragma unroll
    for (int r = 0; r < 9; ++r) {
      float4 s4 = *(const float4*)(sl + r * 1024 + wave * 128 + k4 * 4);
      acc[r].x += s4.x * w0.x + s4.y * w1.x + s4.z * w2.x + s4.w * w3.x;
      acc[r].y += s4.x * w0.y + s4.y * w1.y + s4.z * w2.y + s4.w * w3.y;
      acc[r].z += s4.x * w0.z + s4.y * w1.z + s4.z * w2.z + s4.w * w3.z;
      acc[r].w += s4.x * w0.w + s4.y * w1.w + s4.z * w2.w + s4.w * w3.w;
    }
  }
#pragma unroll
  for (int r = 0; r < 9; ++r) *(float4*)(red + (wave * 9 + r) * 256 + lane * 4) = acc[r];
  __syncthreads();
  float* mod = (float*)(P.ws + WS_MOD);
  for (int o = tid; o < 2304; o += 512) {
    int r = o >> 8, cc = o & 255;
    float sacc = P.b_ada[l * NMOD + cch * 256 + cc];
#pragma unroll
    for (int w = 0; w < 8; ++w) sacc += red[(w * 9 + r) * 256 + cc];
    mod[((size_t)l * 9 + r) * NMOD + cch * 256 + cc] = sacc;
  }
  __syncthreads();
}

DI void phase0(const Params& P, unsigned char* lds, int wv) {
  const int NMODI = 36, NTR = 1232;
  const int total = NMODI + NTR + 1;
  const int tid = get_tid(wv);
  for (int it = get_bid(); it < total; it += gridDim.x) {
    if (it < NMODI) p0_mod_item(P, lds, it, tid);
    else if (it < NMODI + NTR) p0_transpose_item(P, lds, 0, it - NMODI, tid);
    else {
      float* tab = (float*)(P.ws + WS_ROPE);
      for (int e = tid; e < 1024; e += 512) {
        int pos = e >> 4, i = e & 15;
        float inv = powf(10000.f, -(float)(2 * i) / 32.f);
        float ang = (float)pos * inv;
        tab[e * 2] = cosf(ang); tab[e * 2 + 1] = sinf(ang);
      }
    }
  }
}

DI float wave_sum(float v, int lane) {
#pragma unroll
  for (int o = 32; o >= 1; o >>= 1) v += shx(v, o, lane);
  return v;
}

DI void sw_item(const Params& P, unsigned char* lds, const int l, const int r, const int tid) {
  const int wave = tid >> 6, lane = tid & 63;
  const float* mod = (const float*)(P.ws + WS_MOD);
  u16* shl = (u16*)lds;
  const int ql = lane & 31, hl = lane >> 5;
  {
    int st, ch;
    if (r < 22) { st = 0; ch = r; } else if (r < 29) { st = 1; ch = r - 22; } else { st = 2; ch = r - 29; }
    const u16* wt = (const u16*)(P.ws + WS_WT) + (size_t)l * WT_LAYER + (st == 0 ? 0 : (st == 1 ? 2 * WT_UP + 2 * WT_DN : WT_UP + WT_DN));
    for (int i = tid; i < 9 * 1024; i += 512) {
      const float v = mod[((size_t)l * 9 + (i >> 10)) * NMOD + (st * 3) * 1024 + (i & 1023)];
      const u16 hi = f2bf(v);
      shl[(i >> 10) * 1032 + (i & 1023)] = hi;
      shl[9 * 1032 + (i >> 10) * 1032 + (i & 1023)] = f2bf(v - bf2f(hi));
    }
    __syncthreads();
    const int n0 = ch * 256 + wave * 32;
    const u16* wrow = wt + (size_t)(n0 + ql) * 1024 + hl * 8;
    f32x16 acc;
#pragma unroll
    for (int i = 0; i < 16; ++i) acc[i] = 0.f;
#pragma unroll 8
    for (int kk = 0; kk < 64; ++kk) {
      const bf16x8 aw = *(const bf16x8*)(wrow + kk * 16);
      bf16x8 bh = (bf16x8){0, 0, 0, 0, 0, 0, 0, 0}, bl = (bf16x8){0, 0, 0, 0, 0, 0, 0, 0};
      if (ql < 9) {
        bh = *(const bf16x8*)(shl + ql * 1032 + kk * 16 + hl * 8);
        bl = *(const bf16x8*)(shl + 9 * 1032 + ql * 1032 + kk * 16 + hl * 8);
      }
      acc = __builtin_amdgcn_mfma_f32_32x32x16_bf16(aw, bh, acc, 0, 0, 0);
      acc = __builtin_amdgcn_mfma_f32_32x32x16_bf16(aw, bl, acc, 0, 0, 0);
    }
    if (ql < 9) {
      float* swo = (float*)(P.ws + WS_SW) + ((size_t)(l * 3 + st) * 9 + ql) * SW_LD + n0 + hl * 4;
#pragma unroll
      for (int j = 0; j < 4; ++j) *(float4*)(swo + 8 * j) = make_float4(acc[4 * j], acc[4 * j + 1], acc[4 * j + 2], acc[4 * j + 3]);
    }
    __syncthreads();
  }
}

DI void phase0b(const Params& P, unsigned char* lds, int wv) {
  const int tid = get_tid(wv);
  const int wave = tid >> 6, lane = tid & 63;
  const int bid = get_bid(), G = gridDim.x;
  const float* mod = (const float*)(P.ws + WS_MOD);
  for (int it = bid; it < 51; it += G) sw_item(P, lds, 0, it, tid);
  u16* hg = (u16*)(P.ws + WS_A);
  float* ssp = (float*)(P.ws + WS_SSP);
  for (int row = bid * 8 + wave; row < M_ALL; row += G * 8) {
    const float* src = row < M_LAT ? P.x + (size_t)row * DM : P.ctx + (size_t)(row - M_LAT) * DM;
    const int bi = row < M_LAT ? (row >> 11) : 8;
    const float* sc = mod + bi * NMOD + 1024;
    float ss = 0.f;
#pragma unroll
    for (int i = 0; i < 4; ++i) {
      const int c = i * 256 + lane * 4;
      const float4 v = *(const float4*)(src + c);
      ss += v.x * v.x + v.y * v.y + v.z * v.z + v.w * v.w;
      const float4 gg = *(const float4*)(P.norm_g + c), s4 = *(const float4*)(sc + c);
      u32x2 o; o[0] = pk2(v.x * gg.x * (1.f + s4.x), v.y * gg.y * (1.f + s4.y)); o[1] = pk2(v.z * gg.z * (1.f + s4.z), v.w * gg.w * (1.f + s4.w));
      *(u32x2*)(hg + (size_t)row * DM + c) = o;
    }
    ss = wave_sum(ss, lane);
    if (lane == 0) {
      const float z = ss * 0.f;
      if (row < M_LAT) *(float4*)(ssp + (size_t)row * 4) = make_float4(ss, z, z, z);
      else { float* q_ = ssp + (size_t)M_ALL * 4 + (size_t)(row - M_LAT) * 8; *(float4*)q_ = make_float4(ss, z, z, z); *(float4*)(q_ + 4) = make_float4(z, z, z, z); }
    }
  }
}

DI void final_phase(const Params& P, int wv) {
  const int tid = get_tid(wv);
  const int wave = tid >> 6, lane = tid & 63;
  const float* h = (const float*)(P.ws + WS_H);
  for (int row = get_bid() * 8 + wave; row < M_LAT; row += gridDim.x * 8) {
    const float* src = h + (size_t)row * DM;
    float4 v[4]; float ss = 0.f;
#pragma unroll
    for (int i = 0; i < 4; ++i) {
      v[i] = *(const float4*)(src + i * 256 + lane * 4);
      ss += v[i].x * v[i].x + v[i].y * v[i].y + v[i].z * v[i].z + v[i].w * v[i].w;
    }
    ss = wave_sum(ss, lane);
    const float r = rsqrtf(ss * (1.f / 1024.f) + 1e-6f);
#pragma unroll
    for (int i = 0; i < 4; ++i) {
      int c = i * 256 + lane * 4;
      float4 gg = *(const float4*)(P.final_g + c);
      float4 o = make_float4(v[i].x * r * gg.x, v[i].y * r * gg.y, v[i].z * r * gg.z, v[i].w * r * gg.w);
      *(float4*)(P.out + (size_t)row * DM + c) = o;
    }
  }
}

DI void pp_normrope_one(u16* ptr, const float* __restrict__ g, bool rope, int pos, const float* __restrict__ tab, unsigned char* img, int swz) {
  float x[64];
#pragma unroll
  for (int i = 0; i < 8; ++i) {
    u32x4 raw = *(const u32x4*)(ptr + i * 8);
#pragma unroll
    for (int j = 0; j < 4; ++j) { x[i * 8 + 2 * j] = bf_lo(raw[j]); x[i * 8 + 2 * j + 1] = bf_hi(raw[j]); }
  }
  float ss = 0.f;
#pragma unroll
  for (int d = 0; d < 64; ++d) ss += x[d] * x[d];
  const float r = rsqrtf(ss * (1.f / 64.f) + 1e-6f);
#pragma unroll
  for (int d = 0; d < 64; ++d) x[d] = x[d] * r * g[d];
  if (rope) {
    const float2* tr = (const float2*)tab + (pos >> 6) * 16;
    const float2* tc = (const float2*)tab + (pos & 63) * 16;
#pragma unroll
    for (int i = 0; i < 16; ++i) {
      float2 cs = tr[i];
      float x1 = x[i], x2 = x[16 + i];
      x[i] = x1 * cs.x - x2 * cs.y; x[16 + i] = x1 * cs.y + x2 * cs.x;
      float2 cs2 = tc[i];
      float y1 = x[32 + i], y2 = x[48 + i];
      x[32 + i] = y1 * cs2.x - y2 * cs2.y; x[48 + i] = y1 * cs2.y + y2 * cs2.x;
    }
  }
#pragma unroll
  for (int i = 0; i < 8; ++i) {
    u32x4 o;
#pragma unroll
    for (int j = 0; j < 4; ++j) o[j] = pk2(x[i * 8 + 2 * j], x[i * 8 + 2 * j + 1]);
    *(u32x4*)(ptr + i * 8) = o;
    if (img) *(u32x4*)(img + ((i ^ swz) << 4)) = o;
  }
}

DI void pool_item(const Params& P, unsigned char* lds, const int l, const int tt, const int tid) {
  const u16* p = (const u16*)(P.ws + WS_P);
  u16* mix = (u16*)(P.ws + WS_MIX);
  const int row0 = tt * 64;
  const bool lat = row0 < M_LAT;
  {
      u16* U = (u16*)lds;
      float* Y = (float*)(lds + 80 * 256 * 2);
      int s0, n;
      if (lat) { s0 = (row0 >> 11) << 11; n = 2048; } else { s0 = M_LAT + (((row0 - M_LAT) >> 8) << 8); n = 256; }
      const int t0 = row0 - s0;
      for (int idx = tid; idx < 80 * 32; idx += 512) {
        int rr = idx >> 5, c8 = idx & 31;
        int t = t0 - 8 + rr;
        u32x4 v = (u32x4){0u, 0u, 0u, 0u};
        if (t >= 0 && t < n) v = *(const u32x4*)(p + (size_t)(s0 + t) * DIN + 768 + c8 * 8);
        *(u32x4*)(U + rr * 256 + c8 * 8) = v;
      }
      __syncthreads();
      {
        const int ch = tid & 255, tg = tid >> 8, g = ch >> 6, w = 2 << g;
        for (int tk = 0; tk < 32; ++tk) {
          int tok = tg * 32 + tk, t = t0 + tok;
          int lo = max(t - (w >> 1), 0), hi = min(t - (w >> 1) + w, n);
          float s = 0.f;
          for (int q = lo; q < hi; ++q) s += bf2f(U[(q - t0 + 8) * 256 + ch]);
          float mean = s / (float)(hi - lo);
          Y[tok * 256 + ch] = mean - bf2f(U[(tok + 8) * 256 + ch]);
        }
      }
      __syncthreads();
      {
        const int dcol = tid & 255, tg = tid >> 8, g = dcol >> 6, d = dcol & 63;
        const float* pw = P.pool_w + ((size_t)(l * 4 + g) * 64) * 64 + d;
        float acc[32];
#pragma unroll
        for (int tk = 0; tk < 32; ++tk) acc[tk] = 0.f;
        for (int c4 = 0; c4 < 16; ++c4) {
          float w0 = pw[(c4 * 4 + 0) * 64], w1 = pw[(c4 * 4 + 1) * 64], w2 = pw[(c4 * 4 + 2) * 64], w3 = pw[(c4 * 4 + 3) * 64];
#pragma unroll
          for (int tk = 0; tk < 32; ++tk) {
            float4 yv = *(const float4*)(Y + (tg * 32 + tk) * 256 + g * 64 + c4 * 4);
            acc[tk] += yv.x * w0 + yv.y * w1 + yv.z * w2 + yv.w * w3;
          }
        }
        const float psc = P.pool_scale[l * 256 + dcol];
#pragma unroll
        for (int tk = 0; tk < 32; ++tk)
          mix[(size_t)(row0 + tg * 32 + tk) * DM + 256 + dcol] = f2bf(acc[tk] * psc);
      }
      __syncthreads();
  }
}

DI void pp_phase(const Params& P, unsigned char* lds, int l, int wv) {
  u16* p = (u16*)(P.ws + WS_P);
  const float* tab = (const float*)(P.ws + WS_ROPE);
  for (int blk = get_bid(); blk < 256; blk += gridDim.x) {
    const int tid = get_tid(wv);
    const int row0 = blk * 72;
    if (tid < 144) {
      const int token = tid >> 1, kh = tid & 1, row = row0 + token;
      const bool lat = row < M_LAT;
      int bb, kidx;
      if (lat) { bb = row >> 11; kidx = row & 2047; } else { int rc = row - M_LAT; bb = rc >> 8; kidx = 2048 + (rc & 255); }
      unsigned char* img = P.ws + WS_KC + ((size_t)((bb * 2 + kh) * 36 + (kidx >> 6))) * 8192 + (kidx & 63) * 128;
      pp_normrope_one(p + (size_t)row * DIN + 1536 + kh * 64, P.k_norm_g + l * 64, lat, row & 2047, tab, img, ((kidx & 63) >> 1) & 7);
    }
    u16* T = (u16*)lds;
#pragma unroll
    for (int hv = 0; hv < 6; ++hv) {
      const int col = hv < 4 ? 512 + hv * 64 : 1664 + (hv - 4) * 64;
      for (int idx = tid; idx < 576; idx += 512) {
        const int token = idx >> 3, dc = idx & 7;
        const u32x4 v = *(const u32x4*)(p + (size_t)(row0 + token) * DIN + col + dc * 8);
#pragma unroll
        for (int j = 0; j < 4; ++j) {
          T[(hv * 64 + dc * 8 + 2 * j) * 80 + token] = (u16)(v[j] & 0xffffu);
          T[(hv * 64 + dc * 8 + 2 * j + 1) * 80 + token] = (u16)(v[j] >> 16);
        }
      }
    }
#pragma unroll
    for (int hk = 0; hk < 4; ++hk) {
      for (int idx = tid; idx < 576; idx += 512) {
        const int token = idx >> 3, dc = idx & 7, row = row0 + token;
        int b, keypos;
        if (row < M_LAT) { b = row >> 11; keypos = row & 2047; } else { int rc = row - M_LAT; b = rc >> 8; keypos = 2048 + (rc & 255); }
        const u32x4 v = *(const u32x4*)(p + (size_t)row * DIN + 256 + hk * 64 + dc * 8);
        const int key = keypos & 63;
        *(u32x4*)(P.ws + WS_KA + ((size_t)((b * 4 + hk) * 36 + (keypos >> 6))) * IMG_TILE + key * 128 + ((dc ^ ((key >> 1) & 7)) << 4)) = v;
      }
    }
    __syncthreads();
#pragma unroll
    for (int hv = 0; hv < 6; ++hv) {
      for (int idx = tid; idx < 576; idx += 512) {
        const int d = idx / 9, gi = idx - d * 9, row = row0 + gi * 8;
        int b, keypos;
        if (row < M_LAT) { b = row >> 11; keypos = row & 2047; } else { int rc = row - M_LAT; b = rc >> 8; keypos = 2048 + (rc & 255); }
        const u32x4 o = *(const u32x4*)(T + (hv * 64 + d) * 80 + gi * 8);
        unsigned char* dst = hv < 4 ? P.ws + WS_VA + ((size_t)((b * 4 + hv) * 36 + (keypos >> 6))) * IMG_TILE
                                    : P.ws + WS_VC + ((size_t)((b * 2 + hv - 4) * 36 + (keypos >> 6))) * IMG_TILE;
        *(u32x4*)(dst + d * 128 + ((((keypos & 63) >> 3) ^ ((d >> 1) & 7)) << 4)) = o;
      }
    }
    __syncthreads();
  }
}


template <int I0, int I1>
DI void na_softmax(f32x16& sc, f32x16& o0, f32x16& o1, float& mrun, float& lsum, const float* __restrict__ brow_, const int kcb,
                   const int w0, const int qcol, const float cs, const int lane) {
#pragma unroll
  for (int i = I0; i < I1; ++i) {
    const int kc = kcb + 8 * (i >> 2) + (i & 3);
    const bool valid = (kc >= w0) && (kc < w0 + 16);
    const int dx = min(max(kc - qcol, -15), 15) + 15;
    const float bv = brow_[dx];
    sc[i] = valid ? sc[i] * cs + bv : -1e30f;
  }
  float tmax = sc[I0];
#pragma unroll
  for (int i = I0 + 1; i < I1; ++i) tmax = fmaxf(tmax, sc[i]);
  tmax = fmaxf(tmax, shx(tmax, 32, lane));
  if (__builtin_amdgcn_ballot_w64(tmax > mrun + 4.f) != 0ull) {
    const float mnew = fmaxf(mrun, tmax);
    const float alpha = __builtin_amdgcn_exp2f(mrun - mnew);
    mrun = mnew;
    lsum *= alpha;
#pragma unroll
    for (int i = 0; i < 16; ++i) { o0[i] *= alpha; o1[i] *= alpha; }
  }
  float ps = 0.f;
#pragma unroll
  for (int i = 0; i < 16; ++i) {
    if (i >= I0 && i < I1) { sc[i] = __builtin_amdgcn_exp2f(sc[i] - mrun); ps += sc[i]; }
    else sc[i] = 0.f;
  }
  lsum += ps;
}


template <bool ROPE>
DI void q_normrope(bf16x8 (&bq)[4], const float* __restrict__ g, const float* __restrict__ tab, const int pos, const int hl, const int lane) {
  float x[4][8];
  float ss = 0.f;
#pragma unroll
  for (int ks = 0; ks < 4; ++ks) {
    const u32x4 raw = __builtin_bit_cast(u32x4, bq[ks]);
#pragma unroll
    for (int j = 0; j < 4; ++j) { x[ks][2 * j] = bf_lo(raw[j]); x[ks][2 * j + 1] = bf_hi(raw[j]); }
#pragma unroll
    for (int e = 0; e < 8; ++e) ss += x[ks][e] * x[ks][e];
  }
  ss += shx(ss, 32, lane);
  const float rs = rsqrtf(ss * (1.f / 64.f) + 1e-6f);
#pragma unroll
  for (int ks = 0; ks < 4; ++ks) {
    const float4 g0 = *(const float4*)(g + ks * 16 + hl * 8), g1 = *(const float4*)(g + ks * 16 + hl * 8 + 4);
    x[ks][0] *= rs * g0.x; x[ks][1] *= rs * g0.y; x[ks][2] *= rs * g0.z; x[ks][3] *= rs * g0.w;
    x[ks][4] *= rs * g1.x; x[ks][5] *= rs * g1.y; x[ks][6] *= rs * g1.z; x[ks][7] *= rs * g1.w;
  }
  if (ROPE) {
    const float2* tr = (const float2*)tab + (pos >> 6) * 16 + hl * 8;
    const float2* tc = (const float2*)tab + (pos & 63) * 16 + hl * 8;
#pragma unroll
    for (int e = 0; e < 8; ++e) {
      const float2 a = tr[e];
      const float x1 = x[0][e], x2 = x[1][e];
      x[0][e] = x1 * a.x - x2 * a.y; x[1][e] = x1 * a.y + x2 * a.x;
      const float2 c = tc[e];
      const float y1 = x[2][e], y2 = x[3][e];
      x[2][e] = y1 * c.x - y2 * c.y; x[3][e] = y1 * c.y + y2 * c.x;
    }
  }
#pragma unroll
  for (int ks = 0; ks < 4; ++ks) {
    u32x4 o;
#pragma unroll
    for (int j = 0; j < 4; ++j) o[j] = pk2(x[ks][2 * j], x[ks][2 * j + 1]);
    bq[ks] = __builtin_bit_cast(bf16x8, o);
  }
}


DI void store_ot_tile(u16* __restrict__ rowp, const u32x2 (&pk)[4], const int hl) {
#pragma unroll
  for (int j = 0; j < 4; j += 2) {
    const auto s0 = __builtin_amdgcn_permlane32_swap(pk[j][0], pk[j + 1][0], false, false);
    const auto s1 = __builtin_amdgcn_permlane32_swap(pk[j][1], pk[j + 1][1], false, false);
    u32x4 v; v[0] = s0[0]; v[1] = s1[0]; v[2] = s0[1]; v[3] = s1[1];
    *(u32x4*)(rowp + 8 * j + hl * 8) = v;
  }
}
template <bool NA, bool FIXED>
DI void attn_block(unsigned char* lds, const int tid, const u16* __restrict__ q, const unsigned char* __restrict__ kimg,
                   const unsigned char* __restrict__ vimg, const int tile0, const int nlat, u16* __restrict__ out,
                   const int act_lo, const int r, const int qcol0, const float* __restrict__ rpb_h, const float mfix, const float* __restrict__ qg) {
  const int lane = tid & 63, ql = lane & 31, hl = lane >> 5;
  const int nseq = nlat + 4;
  bf16x8 bq[4];
#pragma unroll
  for (int ks = 0; ks < 4; ++ks) bq[ks] = *(const bf16x8*)(q + (size_t)ql * DIN + ks * 16 + hl * 8);
  if (FIXED) q_normrope<false>(bq, qg, nullptr, 0, hl, lane);
  float* btab = (float*)(lds + 65536);
  if (NA) { if (tid < 465) btab[tid] = rpb_h[tid] * 1.4426950408889634f; }
  const unsigned char* kt = kimg + tid * 16;
  const unsigned char* vt = vimg + tid * 16;
  unsigned char* ldst = lds + tid * 16;
#define AT_TILE(i_) ((i_) < nlat ? tile0 + (i_) : 32 + (i_) - nlat)
#define AT_LOAD(i_) do { const int tl_ = AT_TILE(i_); \
    __builtin_amdgcn_global_load_lds((const unsigned*)(kt + (size_t)tl_ * IMG_TILE), (unsigned*)(ldst + ((i_) & 3) * 16384), 16, 0, 0); \
    __builtin_amdgcn_global_load_lds((const unsigned*)(vt + (size_t)tl_ * IMG_TILE), (unsigned*)(ldst + ((i_) & 3) * 16384 + 8192), 16, 0, 0); } while (0)
  AT_LOAD(0); AT_LOAD(1); AT_LOAD(2);
  f32x16 o0, o1;
#pragma unroll
  for (int i = 0; i < 16; ++i) { o0[i] = 0.f; o1[i] = 0.f; }
  float mrun = -1e30f, lsum = 0.f;
  const float cs = 0.125f * 1.4426950408889634f;
  const int swk = (ql >> 1) & 7;
  const int koff = ql * 128;
  const int voff = ql * 128 + hl * 8;
  const int qcol = qcol0 + ql;
  const int w0 = min(max(qcol - 8, 0), 48);
  for (int t = 0; t < nseq; ++t) {
    if (t + 2 < nseq) asm volatile("s_waitcnt vmcnt(4)" ::: "memory");
    else if (t + 1 < nseq) asm volatile("s_waitcnt vmcnt(2)" ::: "memory");
    else asm volatile("s_waitcnt vmcnt(0)" ::: "memory");
    __builtin_amdgcn_s_barrier();
    if (t + 3 < nseq) AT_LOAD(t + 3);
    const int tile = AT_TILE(t);
    const bool latent = t < nlat;
    if (NA && latent && (tile < act_lo || tile >= act_lo + 8)) continue;
    const unsigned char* sk = lds + (t & 3) * 16384;
    const unsigned char* sv = sk + 8192;
#pragma unroll
    for (int s2 = 0; s2 < 2; ++s2) {
      f32x16 sc;
#pragma unroll
      for (int i = 0; i < 16; ++i) sc[i] = 0.f;
#pragma unroll
      for (int ks = 0; ks < 4; ++ks) {
        bf16x8 ak = *(const bf16x8*)(sk + s2 * 4096 + koff + (((ks * 2 + hl) ^ swk) << 4));
        sc = __builtin_amdgcn_mfma_f32_32x32x16_bf16(ak, bq[ks], sc, 0, 0, 0);
      }
      const bool na_far = NA && latent && (s2 != (qcol0 >> 5));
      if (na_far) {
        const float* brow_ = btab + (tile - r + 7) * 31;
        const int kcb = s2 * 32 + hl * 4;
        if (qcol0 == 0) na_softmax<0, 4>(sc, o0, o1, mrun, lsum, brow_, kcb, w0, qcol, cs, lane);
        else na_softmax<12, 16>(sc, o0, o1, mrun, lsum, brow_, kcb, w0, qcol, cs, lane);
      } else {
      if (!FIXED) {
      float tmax;
      if (NA && latent) {
        const float* brow_ = btab + (tile - r + 7) * 31;
        const int kcb = s2 * 32 + hl * 4;
#pragma unroll
        for (int i = 0; i < 16; ++i) {
          int kc = kcb + 8 * (i >> 2) + (i & 3);
          bool valid = (kc >= w0) && (kc < w0 + 16);
          int dx = min(max(kc - qcol, -15), 15) + 15;
          float bv = brow_[dx];
          sc[i] = valid ? sc[i] * cs + bv : -1e30f;
        }
        tmax = fmaxf(fmaxf(sc[0], sc[1]), fmaxf(sc[2], sc[3]));
#pragma unroll
        for (int i = 4; i < 16; i += 4) tmax = fmaxf(tmax, fmaxf(fmaxf(sc[i], sc[i + 1]), fmaxf(sc[i + 2], sc[i + 3])));
      } else {
        tmax = fmaxf(fmaxf(sc[0], sc[1]), fmaxf(sc[2], sc[3]));
#pragma unroll
        for (int i = 4; i < 16; i += 4) tmax = fmaxf(tmax, fmaxf(fmaxf(sc[i], sc[i + 1]), fmaxf(sc[i + 2], sc[i + 3])));
        tmax *= cs;
      }
      tmax = fmaxf(tmax, shx(tmax, 32, lane));
      if (__builtin_amdgcn_ballot_w64(tmax > mrun + 4.f) != 0ull) {
        const float mnew = fmaxf(mrun, tmax);
        const float alpha = __builtin_amdgcn_exp2f(mrun - mnew);
        mrun = mnew;
        lsum *= alpha;
#pragma unroll
        for (int i = 0; i < 16; ++i) { o0[i] *= alpha; o1[i] *= alpha; }
      }
      }
      {
        const float mref = FIXED ? mfix : mrun;
        const f2_t m2 = {-mref, -mref};
        const f2_t c2 = (NA && latent) ? (f2_t){1.f, 1.f} : (f2_t){cs, cs};
        f2_t ps2 = {0.f, 0.f};
#pragma unroll
        for (int i = 0; i < 16; i += 2) {
          f2_t x = {sc[i], sc[i + 1]};
          x = x * c2 + m2;
          f2_t e = {__builtin_amdgcn_exp2f(x[0]), __builtin_amdgcn_exp2f(x[1])};
          sc[i] = e[0]; sc[i + 1] = e[1];
          ps2 += e;
        }
        lsum += ps2[0] + ps2[1];
      }
      }
#pragma unroll
      for (int kb = 0; kb < 2; ++kb) {
        u32x4 pp;
#pragma unroll
        for (int j = 0; j < 4; ++j) pp[j] = pk2(sc[kb * 8 + 2 * j], sc[kb * 8 + 2 * j + 1]);
        const bf16x8 pb = __builtin_bit_cast(bf16x8, pp);
        u32x4 a0, a1;
        {
          u32x2 x0 = *(const u32x2*)(sv + voff + (((s2 * 4 + kb * 2 + 0) ^ swk) << 4));
          u32x2 x1 = *(const u32x2*)(sv + voff + (((s2 * 4 + kb * 2 + 1) ^ swk) << 4));
          u32x2 y0 = *(const u32x2*)(sv + 4096 + voff + (((s2 * 4 + kb * 2 + 0) ^ swk) << 4));
          u32x2 y1 = *(const u32x2*)(sv + 4096 + voff + (((s2 * 4 + kb * 2 + 1) ^ swk) << 4));
          a0[0] = x0[0]; a0[1] = x0[1]; a0[2] = x1[0]; a0[3] = x1[1];
          a1[0] = y0[0]; a1[1] = y0[1]; a1[2] = y1[0]; a1[3] = y1[1];
        }
        o0 = __builtin_amdgcn_mfma_f32_32x32x16_bf16(__builtin_bit_cast(bf16x8, a0), pb, o0, 0, 0, 0);
        o1 = __builtin_amdgcn_mfma_f32_32x32x16_bf16(__builtin_bit_cast(bf16x8, a1), pb, o1, 0, 0, 0);
      }
    }
  }
#undef AT_LOAD
#undef AT_TILE
  const float ltot = lsum + shx(lsum, 32, lane);
  const float inv = 1.f / ltot;
  {
    u32x2 w0_[4], w1_[4];
#pragma unroll
    for (int j = 0; j < 4; ++j) {
      w0_[j][0] = pk2(o0[4 * j] * inv, o0[4 * j + 1] * inv); w0_[j][1] = pk2(o0[4 * j + 2] * inv, o0[4 * j + 3] * inv);
      w1_[j][0] = pk2(o1[4 * j] * inv, o1[4 * j + 1] * inv); w1_[j][1] = pk2(o1[4 * j + 2] * inv, o1[4 * j + 3] * inv);
    }
    store_ot_tile(out + (size_t)ql * DM, w0_, hl);
    store_ot_tile(out + (size_t)ql * DM + 32, w1_, hl);
  }
  asm volatile("s_waitcnt vmcnt(0)" ::: "memory");
  __builtin_amdgcn_s_barrier();
}


DI void gqa_block2(unsigned char* lds, const int tid, const u16* __restrict__ q, const unsigned char* __restrict__ kimg,
                   const unsigned char* __restrict__ vimg, u16* __restrict__ out, const float mfix,
                   const float* __restrict__ qg, const float* __restrict__ tab, const int pos0) {
  const int lane = tid & 63, ql = lane & 31, hl = lane >> 5;
  bf16x8 bq[2][4];
#pragma unroll
  for (int qt = 0; qt < 2; ++qt)
#pragma unroll
    for (int ks = 0; ks < 4; ++ks) bq[qt][ks] = *(const bf16x8*)(q + (size_t)(qt * 32 + ql) * DIN + ks * 16 + hl * 8);
  q_normrope<true>(bq[0], qg, tab, pos0 + ql, hl, lane);
  q_normrope<true>(bq[1], qg, tab, pos0 + 32 + ql, hl, lane);
  const unsigned char* kt = kimg + tid * 16;
  const unsigned char* vt = vimg + tid * 16;
  unsigned char* ldst = lds + tid * 16;
#define G2_LOAD(i_) do { \
    __builtin_amdgcn_global_load_lds((const unsigned*)(kt + (size_t)(i_) * IMG_TILE), (unsigned*)(ldst + ((i_) & 3) * 16384), 16, 0, 0); \
    __builtin_amdgcn_global_load_lds((const unsigned*)(vt + (size_t)(i_) * IMG_TILE), (unsigned*)(ldst + ((i_) & 3) * 16384 + 8192), 16, 0, 0); } while (0)
  G2_LOAD(0); G2_LOAD(1); G2_LOAD(2);
  f32x16 o[2][2];
#pragma unroll
  for (int qt = 0; qt < 2; ++qt)
#pragma unroll
    for (int i = 0; i < 16; ++i) { o[qt][0][i] = 0.f; o[qt][1][i] = 0.f; }
  f2_t ls[2] = {{0.f, 0.f}, {0.f, 0.f}};
  const float cs = 0.125f * 1.4426950408889634f;
  const f2_t c2 = {cs, cs}, m2 = {-mfix, -mfix};
  const int swk = (ql >> 1) & 7;
  const int koff = ql * 128;
  const int voff = ql * 128 + hl * 8;
  for (int t = 0; t < 36; ++t) {
    if (t + 2 < 36) asm volatile("s_waitcnt vmcnt(4)" ::: "memory");
    else if (t + 1 < 36) asm volatile("s_waitcnt vmcnt(2)" ::: "memory");
    else asm volatile("s_waitcnt vmcnt(0)" ::: "memory");
    __builtin_amdgcn_s_barrier();
    if (t + 3 < 36) G2_LOAD(t + 3);
    const unsigned char* sk = lds + (t & 3) * 16384;
    const unsigned char* sv = sk + 8192;
#pragma unroll
    for (int s2 = 0; s2 < 2; ++s2) {
      f32x16 sc[2];
#pragma unroll
      for (int i = 0; i < 16; ++i) { sc[0][i] = 0.f; sc[1][i] = 0.f; }
      bf16x8 ak[4];
#pragma unroll
      for (int ks = 0; ks < 4; ++ks) ak[ks] = *(const bf16x8*)(sk + s2 * 4096 + koff + (((ks * 2 + hl) ^ swk) << 4));
#pragma unroll
      for (int ks = 0; ks < 4; ++ks) sc[0] = __builtin_amdgcn_mfma_f32_32x32x16_bf16(ak[ks], bq[0][ks], sc[0], 0, 0, 0);
#pragma unroll
      for (int ks = 0; ks < 4; ++ks) sc[1] = __builtin_amdgcn_mfma_f32_32x32x16_bf16(ak[ks], bq[1][ks], sc[1], 0, 0, 0);
      u32x4 a0[2], a1[2];
#pragma unroll
      for (int kb = 0; kb < 2; ++kb) {
        const u32x2 x0 = *(const u32x2*)(sv + voff + (((s2 * 4 + kb * 2 + 0) ^ swk) << 4));
        const u32x2 x1 = *(const u32x2*)(sv + voff + (((s2 * 4 + kb * 2 + 1) ^ swk) << 4));
        const u32x2 y0 = *(const u32x2*)(sv + 4096 + voff + (((s2 * 4 + kb * 2 + 0) ^ swk) << 4));
        const u32x2 y1 = *(const u32x2*)(sv + 4096 + voff + (((s2 * 4 + kb * 2 + 1) ^ swk) << 4));
        a0[kb][0] = x0[0]; a0[kb][1] = x0[1]; a0[kb][2] = x1[0]; a0[kb][3] = x1[1];
        a1[kb][0] = y0[0]; a1[kb][1] = y0[1]; a1[kb][2] = y1[0]; a1[kb][3] = y1[1];
      }
#pragma unroll
      for (int qt = 0; qt < 2; ++qt) {
#pragma unroll
        for (int i = 0; i < 16; i += 2) {
          f2_t x = {sc[qt][i], sc[qt][i + 1]};
          x = x * c2 + m2;
          const f2_t e = {__builtin_amdgcn_exp2f(x[0]), __builtin_amdgcn_exp2f(x[1])};
          sc[qt][i] = e[0]; sc[qt][i + 1] = e[1];
          ls[qt] += e;
        }
#pragma unroll
        for (int kb = 0; kb < 2; ++kb) {
          u32x4 pp;
#pragma unroll
          for (int j = 0; j < 4; ++j) pp[j] = pk2(sc[qt][kb * 8 + 2 * j], sc[qt][kb * 8 + 2 * j + 1]);
          const bf16x8 pb = __builtin_bit_cast(bf16x8, pp);
          o[qt][0] = __builtin_amdgcn_mfma_f32_32x32x16_bf16(__builtin_bit_cast(bf16x8, a0[kb]), pb, o[qt][0], 0, 0, 0);
          o[qt][1] = __builtin_amdgcn_mfma_f32_32x32x16_bf16(__builtin_bit_cast(bf16x8, a1[kb]), pb, o[qt][1], 0, 0, 0);
        }
      }
    }
  }
#undef G2_LOAD
#pragma unroll
  for (int qt = 0; qt < 2; ++qt) {
    const float lsum = ls[qt][0] + ls[qt][1];
    const float inv = 1.f / (lsum + shx(lsum, 32, lane));
    u16* ob = out + (size_t)(qt * 32 + ql) * DM;
    u32x2 w0_[4], w1_[4];
#pragma unroll
    for (int j = 0; j < 4; ++j) {
      w0_[j][0] = pk2(o[qt][0][4 * j] * inv, o[qt][0][4 * j + 1] * inv); w0_[j][1] = pk2(o[qt][0][4 * j + 2] * inv, o[qt][0][4 * j + 3] * inv);
      w1_[j][0] = pk2(o[qt][1][4 * j] * inv, o[qt][1][4 * j + 1] * inv); w1_[j][1] = pk2(o[qt][1][4 * j + 2] * inv, o[qt][1][4 * j + 3] * inv);
    }
    store_ot_tile(ob, w0_, hl);
    store_ot_tile(ob + 32, w1_, hl);
  }
  asm volatile("s_waitcnt vmcnt(0)" ::: "memory");
  __builtin_amdgcn_s_barrier();
}

DI void att_phase(const Params& P, unsigned char* lds, int l, bool last, int wv) {
  const int wave = wv;
  const u16* p = (const u16*)(P.ws + WS_P);
  u16* mix = (u16*)(P.ws + WS_MIX);
  const int bid = get_bid(), G = gridDim.x;
  float mfix;
  {
    const int lane_ = get_tid(wv) & 63;
    float gq = fabsf(P.q_norm_g[l * 64 + lane_]), gk = fabsf(P.k_norm_g[l * 64 + lane_]);
#pragma unroll
    for (int o = 32; o >= 1; o >>= 1) { gq = fmaxf(gq, shx(gq, o, lane_)); gk = fmaxf(gk, shx(gk, o, lane_)); }
    mfix = 8.f * gq * gk * 1.4426950408889634f * 1.03f;
  }
  for (int rep_ = 0; rep_ < ((PROBE_DUP & 32) ? 2 : 1); ++rep_)
  for (int item = bid; item < 256; item += G) {
    const int b = item >> 5, kvh = (item >> 4) & 1, qblk = item & 15;
    const int h = kvh * 4 + (wave >> 1);
    const size_t qrow = (size_t)b * 2048 + qblk * 128 + (wave & 1) * 64;
    gqa_block2(lds, get_tid(wv), p + qrow * DIN + 1024 + h * 64,
               P.ws + WS_KC + (size_t)(b * 2 + kvh) * 36 * IMG_TILE, P.ws + WS_VC + (size_t)(b * 2 + kvh) * 36 * IMG_TILE,
               mix + qrow * DM + 512 + h * 64, mfix, P.q_norm_g + l * 64, (const float*)(P.ws + WS_ROPE), qblk * 128 + (wave & 1) * 64);
  }
  for (int rep_ = 0; rep_ < ((PROBE_DUP & 64) ? 2 : 1); ++rep_)
  for (int item = bid; item < 256; item += G) {
    const int b = item >> 5, h = (item >> 3) & 3, rg = item & 7;
    const int r = rg * 4 + (wave >> 1);
    const int r0 = min(max(r - 4, 0), 24);
    const int u_lo = min(max(rg * 4 - 4, 0), 24), u_hi = min(max(rg * 4 + 3 - 4, 0), 24) + 8;
    const size_t qrow = (size_t)b * 2048 + r * 64 + (wave & 1) * 32;
    attn_block<true, false>(lds, get_tid(wv), p + qrow * DIN + h * 64,
                     P.ws + WS_KA + (size_t)(b * 4 + h) * 36 * IMG_TILE, P.ws + WS_VA + (size_t)(b * 4 + h) * 36 * IMG_TILE,
                     u_lo, u_hi - u_lo, mix + qrow * DM + h * 64, r0, r, (wave & 1) * 32,
                     P.na_rpb + (size_t)(l * 4 + h) * 15 * 31, 0.f, nullptr);
  }
  if (!last) {
    for (int item = bid; item < 96; item += G) {
      if (item < 32) {
        const int b = item >> 2, h = item & 3;
        const size_t qrow = (size_t)M_LAT + b * 256 + wave * 32;
        attn_block<false, false>(lds, get_tid(wv), p + qrow * DIN + h * 64,
                          P.ws + WS_KA + (size_t)(b * 4 + h) * 36 * IMG_TILE, P.ws + WS_VA + (size_t)(b * 4 + h) * 36 * IMG_TILE,
                          0, 0, mix + qrow * DM + h * 64, 0, 0, 0, nullptr, 0.f, nullptr);
      } else {
        const int it2 = item - 32, b = it2 >> 3, h = it2 & 7, kvh = h >> 2;
        const size_t qrow = (size_t)M_LAT + b * 256 + wave * 32;
        attn_block<false, true>(lds, get_tid(wv), p + qrow * DIN + 1024 + h * 64,
                          P.ws + WS_KC + (size_t)(b * 2 + kvh) * 36 * IMG_TILE, P.ws + WS_VC + (size_t)(b * 2 + kvh) * 36 * IMG_TILE,
                          0, 0, mix + qrow * DM + 512 + h * 64, 0, 0, 0, nullptr, mfix, P.q_norm_g + l * 64);
      }
    }
  }
  {
    const int npool = last ? 256 : 288;
    for (int it = (bid + G - (96 % G)) % G; it < npool; it += G) pool_item(P, lds, l, it, get_tid(wv));
  }
}

#define XB_TMO      128
#define XB_XCNT(j)  (256  + 64 * (j))
#define XB_XSUB(j)  (1280 + 64 * (j))
#define XB_XGEN(j)  (2304 + 64 * (j))
#define XB_TOP      3328
#define XB_TOPGEN   3392
#define XB_SPIN_CAP (1u << 22)
#define LAS __attribute__((address_space(3)))
DI unsigned xb_ld(unsigned* p) { return __hip_atomic_load(p, __ATOMIC_RELAXED, __HIP_MEMORY_SCOPE_AGENT); }
DI unsigned xb_add(unsigned* p, unsigned v) { return __hip_atomic_fetch_add(p, v, __ATOMIC_RELAXED, __HIP_MEMORY_SCOPE_AGENT); }
DI unsigned xb_xcc_id() { return (unsigned)__builtin_amdgcn_s_getreg((3 << 11) | 20) & 0xFu; }
#define XB_SPIN(cond, bar) do { unsigned _sp = 0; while (cond) { __builtin_amdgcn_s_sleep(1); \
    if ((++_sp & 255u) == 0u) { if (xb_ld(&(bar)[XB_TMO])) break; if (_sp > XB_SPIN_CAP) { atomicAdd(&(bar)[XB_TMO], 1u); break; } } } } while (0)

DI void xcd_barrier_complete(unsigned* bar, unsigned x, unsigned& nloc, unsigned& nx) {
  const unsigned G = gridDim.x;
  unsigned sum, cnt, mine, sp = 0u;
  for (;;) {
    sum = 0u; cnt = 0u; mine = 0u;
#pragma unroll
    for (unsigned j = 0; j < 16; ++j) { const unsigned c = xb_ld(&bar[XB_XCNT(j)]); sum += c; cnt += (c > 0u) ? 1u : 0u; mine = (j == x) ? c : mine; }
    if (sum == G) break;
    __builtin_amdgcn_s_sleep(1);
    if ((++sp & 255u) == 0u) { if (xb_ld(&bar[XB_TMO])) break; if (sp > XB_SPIN_CAP) { atomicAdd(&bar[XB_TMO], 1u); break; } }
  }
  nloc = mine > 0u ? mine : 1u; nx = cnt > 0u ? cnt : 1u;
}

DI void xcd_barrier(unsigned* bar, const unsigned x, volatile LAS unsigned* st, const int tid) {
  asm volatile("s_waitcnt vmcnt(0)" ::: "memory");
  __syncthreads();
  if (tid == 0) {
    __builtin_amdgcn_s_waitcnt(0);
    unsigned nloc = st[0], nx = st[1];
    if (nloc == 0u) { xcd_barrier_complete(bar, x, nloc, nx); st[0] = nloc; st[1] = nx; }
    const unsigned old = xb_add(&bar[XB_XSUB(x)], 1u);
    const unsigned gen = old / nloc;
    if (old + 1u == (gen + 1u) * nloc) {
      __builtin_amdgcn_fence(__ATOMIC_RELEASE, "agent");
      asm volatile("s_waitcnt vmcnt(0)" ::: "memory");
      const unsigned og = xb_add(&bar[XB_TOP], 1u);
      const unsigned tg = og / nx;
      if (og + 1u == (tg + 1u) * nx) xb_add(&bar[XB_TOPGEN], 1u);
      else XB_SPIN(xb_ld(&bar[XB_TOPGEN]) == tg, bar);
      __builtin_amdgcn_fence(__ATOMIC_ACQUIRE, "agent");
      xb_add(&bar[XB_XGEN(x)], 1u);
      asm volatile("s_waitcnt vmcnt(0)" ::: "memory");
    } else {
      XB_SPIN(xb_ld(&bar[XB_XGEN(x)]) == gen, bar);
      __builtin_amdgcn_fence(__ATOMIC_ACQUIRE, "agent");
      asm volatile("s_waitcnt vmcnt(0)" ::: "memory");
    }
  }
  __syncthreads();
}

DI void drain_bg(const Params& P, unsigned char* lds, const int wv, const int lnext, const int which) {
  unsigned* ctr = (unsigned*)(P.ws + WS_BAR) + 3500 + lnext * 2 + which;
  volatile LAS int* slot = (volatile LAS int*)(lds + LDS_MAIN + 16);
  const int n_items = which == 0 ? 852 : 467;
  for (;;) {
    const int tid = get_tid(wv);
    __syncthreads();
    if (tid == 0) *slot = (int)xb_add(ctr, 1u);
    __syncthreads();
    const int it = *slot;
    if (it >= n_items) break;
    if (which == 0) {
      if (it < 36) p0_mod_item(P, lds, lnext * 36 + it, tid);
      else {
        const int i2 = it - 36;
        const int r = i2 < 352 ? i2 : (i2 < 464 ? 1056 + (i2 - 352) : 528 + (i2 - 464));
        p0_transpose_item(P, lds, lnext, r, tid);
      }
    } else {
      if (it < 416) {
        const int r = it < 176 ? 352 + it : (it < 352 ? 880 + (it - 176) : 1168 + (it - 352));
        p0_transpose_item(P, lds, lnext, r, tid);
      } else sw_item(P, lds, lnext, it - 416, tid);
    }
  }
}

__global__ void __launch_bounds__(512) mega(Params P0) {
  extern __shared__ __attribute__((aligned(16))) unsigned char lds[];
  cg::grid_group grid = cg::this_grid();
  const int wv = __builtin_amdgcn_readfirstlane((int)(threadIdx.x >> 6));
  volatile LAS unsigned* xb_st = (volatile LAS unsigned*)(lds + LDS_MAIN);
  unsigned* xb_bar = (unsigned*)(P0.ws + WS_BAR);
  const unsigned xb_x = xb_xcc_id();
  if (threadIdx.x == 0) { xb_st[0] = 0u; xb_st[1] = 0u; (void)xb_add(&xb_bar[XB_XCNT(xb_x)], 1u); }
  __syncthreads();
  for (int ph = P0.ph_lo; ph < P0.ph_hi; ++ph) {
    Params P = P0;
    {
      __attribute__((address_space(1))) unsigned char* w_ = (__attribute__((address_space(1))) unsigned char*)P0.ws;
      asm volatile("" : "+s"(w_));
      P.ws = (unsigned char*)w_; }
#if PROBE_DUP
    int nrep = 1;
    { const int s_ = (ph == 0) ? 100 : (ph == 1 ? 102 : (ph == NPH - 1 ? 101 : 200));
      if ((PROBE_DUP & 1) && s_ == 4) nrep = 2;
      if ((PROBE_DUP & 2) && (s_ == 0 || s_ == 6)) nrep = 2;
      if ((PROBE_DUP & 4) && s_ == 100) nrep = 2;
      if ((PROBE_DUP & 8) && s_ == 102) nrep = 2;
      if ((PROBE_DUP & 16) && s_ == 2) nrep = 2;
      if ((PROBE_DUP & 256) && (s_ == 1 || s_ == 7)) nrep = 2;
      if ((PROBE_DUP & 512) && s_ == 5) nrep = 2; }
    for (int rep = 0; rep < nrep; ++rep) {
      if (rep) xcd_barrier(xb_bar, xb_x, xb_st, get_tid(wv));
#endif
    if (ph == 0) {
      phase0(P, lds, wv);
    } else if (ph == 1) {
      phase0b(P, lds, wv);
    } else if (ph == NPH - 1) {
      final_phase(P, wv);
    } else {
      const int l = (ph - 2) / 7, s_ = (ph - 2) - l * 7;
      const int s = s_ < 3 ? s_ : s_ + 1;
      const bool last = (l == DEPTH - 1);
      const u16* wt = (const u16*)(P.ws + WS_WT) + (size_t)l * WT_LAYER;
      const float* mod = (const float*)(P.ws + WS_MOD) + (size_t)l * 9 * NMOD;
      float* h = (float*)(P.ws + WS_H);
      const u16* a = (const u16*)(P.ws + WS_A);
      const float* ssp = (const float*)(P.ws + WS_SSP);
      const float* swl = (const float*)(P.ws + WS_SW) + (size_t)l * 3 * 9 * SW_LD;
      if (s == 0 || s == 6) {
        EpiSwiglu E{(u16*)(P.ws + WS_ACT), ssp, s == 0 ? swl : swl + 2 * 9 * SW_LD, (const float*)(lds + LDS_RL), true};
        const u16* B = s == 0 ? wt : wt + WT_UP + WT_DN;
        gemm_phase<1024>(lds, wv, a, B, (last && s == 6) ? M_LAT : M_ALL, 5632, E);
        if (!last) drain_bg(P, lds, wv, l + 1, s == 0 ? 0 : 1);
      } else if (s == 1 || s == 5 || s == 7) {
        EpiResid E;
        const bool fromx = (l == 0 && s == 1);
        E.hin_lat = fromx ? P.x : h;
        E.hin_ctx = fromx ? P.ctx : h + (size_t)M_LAT * DM;
        E.hout = h;
#if PROBE_DUP
        if (rep + 1 < nrep) E.hout = (float*)(P.ws + WS_PROBE);
#endif
        const int gi = s == 1 ? 2 : (s == 5 ? 5 : 8);
        E.gate = mod + gi * 1024;
        E.coef = s == 5 ? 1.f : 0.5f;
        E.do_next = !(last && s == 7);
        E.hg = (u16*)(P.ws + WS_A);
        E.ssp = (float*)(P.ws + WS_SSP);
        E.ssl = (float*)(lds + LDS_SSL);
        if (s == 1) { E.gnext = P.norm_g + (l * 3 + 1) * 1024; E.scnext = mod + 4 * 1024; }
        else if (s == 5) { E.gnext = P.norm_g + (l * 3 + 2) * 1024; E.scnext = mod + 7 * 1024; }
        else { const int ln = last ? l : l + 1; E.gnext = P.norm_g + (ln * 3) * 1024; E.scnext = (const float*)(P.ws + WS_MOD) + (size_t)ln * 9 * NMOD + 1024; }
        const bool do_ctx = !(last && s != 1);
        const u16* Bw = s == 5 ? wt + 2 * WT_UP + 2 * WT_DN + WT_IN : (s == 1 ? wt + WT_UP : wt + 2 * WT_UP + WT_DN);
        const u16* Aop = s == 5 ? (const u16*)(P.ws + WS_MIX) : (const u16*)(P.ws + WS_ACT);
        if (s == 5) gemm_phase<1024>(lds, wv, Aop, Bw, M_LAT, 1024, E);
        else gemm_phase<DFF>(lds, wv, Aop, Bw, M_LAT, 1024, E);
        if (do_ctx) {
          SmallEpi SE;
          SE.hin = fromx ? P.ctx - (size_t)M_LAT * DM : h; SE.hout = E.hout; SE.gate = E.gate + 8 * NMOD; SE.coef = E.coef;
          SE.do_next = E.do_next; SE.hg = E.hg; SE.gnext = E.gnext; SE.scnext = E.scnext + 8 * NMOD;
          SE.sspc = (float*)(P.ws + WS_SSPC); SE.ssl = E.ssl;
          for (int bidx = get_bid(); bidx < 256; bidx += gridDim.x) {
            const int idx = bidx >> 3;
            const int pm = (bidx & 7) * 4 + (idx >> 3), pn = idx & 7;
            if (s == 5) gemm_small_tile<1024>(lds, get_tid(wv), Aop, Bw, M_LAT + pm * 64, pn * 128, SE);
            else gemm_small_tile<DFF>(lds, get_tid(wv), Aop, Bw, M_LAT + pm * 64, pn * 128, SE);
          }
        }
      } else if (s == 2) {
        EpiProj E{(u16*)(P.ws + WS_P), DIN, ssp, swl + 9 * SW_LD, (const float*)(lds + LDS_RL), true, P.ws,
                  P.k_norm_g + l * 64, (const float*)(P.ws + WS_ROPE), (float*)(lds + LDS_SSL)};
        gemm_phase<1024>(lds, wv, a, wt + 2 * WT_UP + 2 * WT_DN, M_ALL, DIN, E);
      } else {
        att_phase(P, lds, l, last, wv);
      }
    }
#if PROBE_DUP
    }
#endif
    if (ph + 1 < P0.ph_hi) {
      if (P0.ph_hi < 0) grid.sync();
      xcd_barrier(xb_bar, xb_x, xb_st, get_tid(wv));
#if (PROBE_DUP & 1024)
      for (int e_ = 0; e_ < 2; ++e_) xcd_barrier(xb_bar, xb_x, xb_st, get_tid(wv));
#endif
    }
  }
}

extern "C" void kernel_launch(void* const* d_in, const int* in_sizes, int n_in, void* d_out, int out_size,
                              void* d_ws, size_t ws_size, hipStream_t stream) {
  static int grid_blocks = 0;
  if (!grid_blocks) {
    if (ws_size < WS_TOTAL + (PROBE_DUP ? (size_t)M_ALL * 1024 * 4 : 0)) { fprintf(stderr, "workspace too small: %zu < %zu\n", ws_size, (size_t)WS_END); grid_blocks = -1; return; }
    int dev = 0, cus = 0, per_cu = 0;
    hipGetDevice(&dev);
    hipDeviceGetAttribute(&cus, hipDeviceAttributeMultiprocessorCount, dev);
    if (hipFuncSetAttribute((const void*)mega, hipFuncAttributeMaxDynamicSharedMemorySize, LDS_BYTES) != hipSuccess)
      fprintf(stderr, "hipFuncSetAttribute failed\n");
    hipOccupancyMaxActiveBlocksPerMultiprocessor(&per_cu, mega, 512, LDS_BYTES);
    if (per_cu < 1) per_cu = 1;
    grid_blocks = cus * per_cu;
    (void)hipGetLastError();
  }
  if (grid_blocks < 0) return;
  hipMemsetAsync((unsigned char*)d_ws + WS_BAR, 0, BAR_BYTES, stream);
  Params p{};
  const float** pp = (const float**)&p;
  for (int i = 0; i < 19; ++i) pp[i] = (const float*)d_in[i];
  p.out = (float*)d_out; p.ws = (unsigned char*)d_ws;
#if MULTI
  for (int ph = 0; ph < NPH; ++ph) {
    p.ph_lo = ph; p.ph_hi = ph + 1;
    hipLaunchKernelGGL(mega, dim3(grid_blocks), dim3(512), LDS_BYTES, stream, p);
  }
#else
  p.ph_lo = 0; p.ph_hi = NPH;
  void* args[] = {&p};
  hipError_t e = hipLaunchCooperativeKernel((void*)mega, dim3(grid_blocks), dim3(512), args, LDS_BYTES, stream);
  if (e != hipSuccess) fprintf(stderr, "cooperative launch failed: %s (grid %d)\n", hipGetErrorString(e), grid_blocks);
#endif
}
```
